# Optimizing an MI355X kernel written in HIP

```python
import jax, jax.numpy as jnp
from jax import lax
import numpy as np

D_MODEL = 1024
BATCH = 8
SEQ = 2048
DEPTH = 4

N_MIXERS = 2
N_CONV_LAYERS = (DEPTH + 1) // 2
N_SG_LAYERS = DEPTH // 2
CONV_WIDTH = 3
CONV_GROUPS = 16
SG_WIDTH = D_MODEL
SG_GROUPS = 8
SG_GROUP_DIM = SG_WIDTH // SG_GROUPS
CHUNK = 128
D_FF = int(-(-(8 * D_MODEL // 3) // 256) * 256) if (8 * D_MODEL) % 3 == 0 else ((8 * D_MODEL // 3) // 256 + 1) * 256
PLE_DIM = 256
RMS_EPS = 1e-6
LN_EPS = 1e-5

kernel_name = "hybrid_shortconv_gmlp_trunk"


def rms_norm(x, g):
    xf = x.astype(jnp.float32)
    var = jnp.mean(xf * xf, axis=-1, keepdims=True)
    return (xf * lax.rsqrt(var + RMS_EPS)).astype(x.dtype) * g


def layer_norm(x, g, b):
    xf = x.astype(jnp.float32)
    mu = jnp.mean(xf, axis=-1, keepdims=True)
    xc = xf - mu
    var = jnp.mean(xc * xc, axis=-1, keepdims=True)
    return (xc * lax.rsqrt(var + LN_EPS)).astype(x.dtype) * g + b


def causal_depthwise_conv(z, w_conv):
    return lax.conv_general_dilated(
        z, w_conv[:, None, :], window_strides=(1,), padding=[(CONV_WIDTH - 1, 0)],
        dimension_numbers=("NWC", "WIO", "NWC"), feature_group_count=z.shape[-1])


def short_conv_mixer(h, w_in, w_conv, w_out):
    bcx = h @ w_in
    b_gate, c_gate, xx = jnp.split(bcx, 3, axis=-1)
    y = causal_depthwise_conv(c_gate * xx, w_conv)
    return (b_gate * y) @ w_out


def spatial_gating_mixer(h, w_in, v_gain, v_bias, w_s, b_s, w_out):
    bsz, s, _ = h.shape
    u, v = jnp.split(h @ w_in, 2, axis=-1)
    v = layer_norm(v, v_gain, v_bias)
    n_chunks = s // CHUNK
    v = v.reshape(bsz, n_chunks, CHUNK, SG_GROUPS, SG_GROUP_DIM)
    causal = jnp.tril(jnp.ones((CHUNK, CHUNK), dtype=bool))
    w_masked = jnp.where(causal[None], w_s, jnp.zeros_like(w_s))
    mixed = jnp.einsum("gts,bcsgd->bctgd", w_masked, v) + b_s.T[:, :, None]
    y = u * mixed.reshape(bsz, s, SG_WIDTH)
    return y @ w_out


def swiglu_ffn(h, w_gate, w_up, w_down):
    return (jax.nn.silu(h @ w_gate) * (h @ w_up)) @ w_down


def setup_inputs(seed: int = 0) -> dict:
    key = jax.random.key(seed)
    ks = jax.random.split(key, 24)
    f32 = jnp.float32
    D = D_MODEL

    def nrm(k, shape, scale):
        return jax.random.normal(k, shape, f32) * scale

    def gain(k, shape):
        return 1.0 + 0.02 * jax.random.normal(k, shape, f32)

    causal = np.tril(np.ones((CHUNK, CHUNK), dtype=np.float32))
    return {
        "x": nrm(ks[0], (BATCH, SEQ, D), 1.0),
        "p": nrm(ks[1], (DEPTH, BATCH, SEQ, PLE_DIM), 1.0),
        "mix_norm": gain(ks[2], (DEPTH, D)),
        "conv_w_in": nrm(ks[3], (N_CONV_LAYERS, D, 3 * D), D ** -0.5),
        "conv_w": nrm(ks[4], (N_CONV_LAYERS, CONV_WIDTH, D), CONV_WIDTH ** -0.5),
        "conv_w_out": nrm(ks[5], (N_CONV_LAYERS, D, D), D ** -0.5),
        "sg_w_in": nrm(ks[6], (N_SG_LAYERS, D, 2 * SG_WIDTH), D ** -0.5),
        "sg_v_gain": gain(ks[7], (N_SG_LAYERS, SG_WIDTH)),
        "sg_v_bias": nrm(ks[8], (N_SG_LAYERS, SG_WIDTH), 0.02),
        "sg_w_spatial": nrm(ks[9], (N_SG_LAYERS, SG_GROUPS, CHUNK, CHUNK), 0.5 * CHUNK ** -0.5) * causal,
        "sg_b_spatial": gain(ks[10], (N_SG_LAYERS, SG_GROUPS, CHUNK)),
        "sg_w_out": nrm(ks[11], (N_SG_LAYERS, SG_WIDTH, D), SG_WIDTH ** -0.5),
        "ffn_norm": gain(ks[12], (DEPTH, D)),
        "ffn_w_gate": nrm(ks[13], (DEPTH, D, D_FF), D ** -0.5),
        "ffn_w_up": nrm(ks[14], (DEPTH, D, D_FF), D ** -0.5),
        "ffn_w_down": nrm(ks[15], (DEPTH, D_FF, D), D_FF ** -0.5),
        "ple_norm": gain(ks[16], (DEPTH, D)),
        "ple_w_gate": nrm(ks[17], (DEPTH, D, D), D ** -0.5),
        "ple_w_proj": nrm(ks[18], (DEPTH, PLE_DIM, D), 0.5 * PLE_DIM ** -0.5),
        "final_norm": gain(ks[19], (D,)),
    }


def reference(x, p, mix_norm, conv_w_in, conv_w, conv_w_out, sg_w_in, sg_v_gain, sg_v_bias,
              sg_w_spatial, sg_b_spatial, sg_w_out, ffn_norm, ffn_w_gate, ffn_w_up, ffn_w_down,
              ple_norm, ple_w_gate, ple_w_proj, final_norm):
    h = x
    for i in range(DEPTH):
        j = i // N_MIXERS
        hn = rms_norm(h, mix_norm[i])
        if i % N_MIXERS == 0:
            mix = short_conv_mixer(hn, conv_w_in[j], conv_w[j], conv_w_out[j])
        else:
            mix = spatial_gating_mixer(hn, sg_w_in[j], sg_v_gain[j], sg_v_bias[j],
                                       sg_w_spatial[j], sg_b_spatial[j], sg_w_out[j])
        h = h + mix
        h = h + swiglu_ffn(rms_norm(h, ffn_norm[i]), ffn_w_gate[i], ffn_w_up[i], ffn_w_down[i])
        gate = jax.nn.sigmoid(rms_norm(h, ple_norm[i]) @ ple_w_gate[i])
        h = h + gate * (p[i] @ ple_w_proj[i])
    return rms_norm(h, final_norm)
```

```cpp
#include <hip/hip_runtime.h>
#include <hip/hip_cooperative_groups.h>
#include <cstdio>
#include <cstdint>
#include <type_traits>
namespace cg = cooperative_groups;

namespace pg8 {
#define PG8_LAS __attribute__((address_space(3)))
typedef unsigned short bf16_t;
typedef short bf16x8 __attribute__((ext_vector_type(8)));
typedef float f32x4 __attribute__((ext_vector_type(4)));
typedef unsigned u32x4 __attribute__((ext_vector_type(4)));
constexpr int BM = 256, BK = 64, HALF = 128, HTB = HALF * BK * 2  , STAGE_BYTES = 8 * HTB, NXCD = 8, WGM = 8;

__host__ __device__ __forceinline__ int lds_byte(int r, int c) { const int st = (r >> 4) * 2 + (c >> 5), rr = r & 15, cc = c & 31, ob = rr * 64 + cc * 2; return st * 1024 + (ob ^ (((ob >> 9) & 1) << 5)); }
__host__ __device__ __forceinline__ void stage_rc(int b, int& R, int& C) { const int st = b / 1024, sb = b % 1024, swz = sb ^ (((sb >> 9) & 1) << 5); R = (st >> 1) * 16 + swz / 64; C = (st & 1) * 32 + (swz % 64) / 2; }
__host__ __device__ __forceinline__ int perm32(int rho) { const int n = rho >> 4, i = rho & 15; return 8 * (i >> 2) + 4 * n + (i & 3); }

struct Unit { int pm, pn; };
struct Gemm { const bf16_t* A; const bf16_t* Bt; int M, N, K; };

struct StaticOrder {
    int nM, nN, nwg, G, c;
    __host__ __device__ void init(int M, int N, int G_, int c_) { nM = M / BM; nN = N / BM; nwg = nM * nN; G = G_; c = c_; }
    __host__ __device__ bool next(int i, Unit& u) const {
        const long L = (long)i * G + c; if (L >= nwg) return false;
        int wgid = (int)L; { const int q = nwg / NXCD, r = nwg % NXCD, xcd = wgid % NXCD, off = wgid / NXCD; wgid = (xcd < r ? xcd * (q + 1) : r * (q + 1) + (xcd - r) * q) + off; }
        const int nig = WGM * nN, gid = wgid / nig, fm = gid * WGM, gsz = (nM - fm) < WGM ? (nM - fm) : WGM;
        u.pm = fm + ((wgid % nig) % gsz); u.pn = (wgid % nig) / gsz; return true;
    }
    __device__ __forceinline__ void a_ready(const Unit&) const {}
    __device__ __forceinline__ void done(const Unit&) const {}
};

__device__ __forceinline__ unsigned cvt_pk_bf16(float lo, float hi) { unsigned r; asm volatile("v_cvt_pk_bf16_f32 %0, %1, %2" : "=v"(r) : "v"(lo), "v"(hi)); return r; }
typedef float f32x2 __attribute__((ext_vector_type(2)));
typedef unsigned u32x2 __attribute__((ext_vector_type(2)));
enum { MODE_CONV_IN = 0, MODE_SG_IN = 1, MODE_FFN_UP = 2, MODE_RES = 3, MODE_PLE = 4, MODE_PROJ = 5, MODE_NOP = 6 };
__device__ __forceinline__ float bflo(unsigned u) { return __uint_as_float(u << 16); }
__device__ __forceinline__ float bfhi(unsigned u) { return __uint_as_float(u & 0xffff0000u); }
__device__ __forceinline__ float sigm(float z) { return __builtin_amdgcn_rcpf(1.0f + __builtin_amdgcn_exp2f(z * -1.4426950408889634f)); }
constexpr int EPI_P_OFF = 131072 + 4096;
constexpr size_t EW_ST0 = 1u << 20, EW_ST1 = 2u << 20, EW_VST = 3u << 20, EW_HB0 = 142u << 20, EW_HB1 = 174u << 20, EW_PROJ = 206u << 20, EW_R = 238u << 20;
#ifndef EPI_GRP
#define EPI_GRP 2
#endif
#ifndef WT_STORES
#define WT_STORES 1
#endif
__device__ __forceinline__ void st16(bf16_t* base, unsigned elem_off, u32x4 w) {
#if WT_STORES
    __builtin_amdgcn_raw_buffer_store_b128(w, __builtin_amdgcn_make_buffer_rsrc(base, 0, 0x10000000, 0x00020000), elem_off * 2u, 0, 16);
#else
    *(u32x4*)(base + elem_off) = w;
#endif
}
struct Epi {
    static constexpr int GRP = EPI_GRP;
    static constexpr bool PERM = true, AFTER_DRAIN = false;
    int mode, sb;
    unsigned char* ws;
    __device__ __forceinline__ bool uses_rs() const { return mode == MODE_CONV_IN || mode == MODE_SG_IN || mode == MODE_FFN_UP || mode == MODE_PLE; }
    __device__ __forceinline__ void load_sv(const Unit& u, int wr, int fr, f32x4 (&sv)[8]) const {
        const float* stats_in = (const float*)(ws + (sb ? EW_ST1 : EW_ST0)); const int row0 = u.pm * BM + wr * 64 + fr;
#pragma unroll
        for (int i = 0; i < 8; ++i) sv[i] = *(const f32x4*)(stats_in + (size_t)(row0 + (i >> 2) * HALF + (i & 3) * 16) * 4);
    }
    static __device__ __forceinline__ void reduce_sv(const f32x4 (&sv)[8], float (&rsv)[8]) {
#pragma unroll
        for (int i = 0; i < 8; ++i) rsv[i] = __builtin_amdgcn_rsqf(((sv[i][0] + sv[i][1]) + (sv[i][2] + sv[i][3])) * (1.0f / 1024.0f) + 1e-6f);
    }
    __device__ __forceinline__ void operator()(f32x4 (&acc)[2][2][4][2], const Unit& u, const Unit& nxt, bool has_next, float (&rsv)[8], int wr, int wc, int fr, int fq, PG8_LAS unsigned char* lds) const {
        const int row0 = u.pm * BM + wr * 64 + fr;
        const int cl = wc * 32 + 8 * fq;
        const int md = mode;
        bf16_t* o0 = (bf16_t*)(ws + EW_R); bf16_t* o1 = (bf16_t*)(ws + EW_R + (32u << 20));
        if (md == MODE_RES || md == MODE_PLE) {
            const bf16_t* hc = (const bf16_t*)(ws + (sb ? EW_HB1 : EW_HB0)); bf16_t* hn = (bf16_t*)(ws + (sb ? EW_HB0 : EW_HB1)); const bf16_t* proj = (const bf16_t*)(ws + EW_PROJ);
            PG8_LAS float* P = (PG8_LAS float*)(lds + EPI_P_OFF);
            auto run = [&](auto grp_c, auto ple_c) { constexpr int GRPL = decltype(grp_c)::value; constexpr bool ISPLE = decltype(ple_c)::value;
#pragma unroll
            for (int gi = 0; gi < 8; gi += GRPL) {
                u32x4 hv[GRPL][2], pv[GRPL][2];
#pragma unroll
                for (int mm = 0; mm < GRPL; ++mm)
#pragma unroll
                    for (int bj = 0; bj < 2; ++bj) { const int ai = (gi + mm) >> 2, m = (gi + mm) & 3; const size_t off = (size_t)(row0 + ai * HALF + m * 16) * 1024 + u.pn * 256 + bj * HALF + cl;
                        hv[mm][bj] = *(const u32x4*)(hc + off); if (ISPLE) pv[mm][bj] = *(const u32x4*)(proj + off); }
#pragma unroll
                for (int mm = 0; mm < GRPL; ++mm) { const int ai = (gi + mm) >> 2, m = (gi + mm) & 3; const float rs = rsv[gi + mm]; float q = 0.f;
#pragma unroll
                    for (int bj = 0; bj < 2; ++bj) { const size_t off = (size_t)(row0 + ai * HALF + m * 16) * 1024 + u.pn * 256 + bj * HALF + cl;
                        f32x4 d0 = acc[ai][bj][m][0], d1 = acc[ai][bj][m][1];
                        if (ISPLE) { const u32x4 pw = pv[mm][bj];
                            d0 = (f32x4){sigm(d0[0] * rs) * bflo(pw.x), sigm(d0[1] * rs) * bfhi(pw.x), sigm(d0[2] * rs) * bflo(pw.y), sigm(d0[3] * rs) * bfhi(pw.y)};
                            d1 = (f32x4){sigm(d1[0] * rs) * bflo(pw.z), sigm(d1[1] * rs) * bfhi(pw.z), sigm(d1[2] * rs) * bflo(pw.w), sigm(d1[3] * rs) * bfhi(pw.w)}; }
                        const u32x4 hw = hv[mm][bj];
                        const f32x4 h0 = (f32x4){bflo(hw.x), bfhi(hw.x), bflo(hw.y), bfhi(hw.y)} + d0, h1 = (f32x4){bflo(hw.z), bfhi(hw.z), bflo(hw.w), bfhi(hw.w)} + d1;
                        q += ((h0[0] * h0[0] + h0[1] * h0[1]) + (h0[2] * h0[2] + h0[3] * h0[3])) + ((h1[0] * h1[0] + h1[1] * h1[1]) + (h1[2] * h1[2] + h1[3] * h1[3]));
                        u32x4 w; w.x = cvt_pk_bf16(h0[0], h0[1]); w.y = cvt_pk_bf16(h0[2], h0[3]); w.z = cvt_pk_bf16(h1[0], h1[1]); w.w = cvt_pk_bf16(h1[2], h1[3]);
                        st16(hn, (unsigned)off, w); }
                    q += __shfl_xor(q, 16); q += __shfl_xor(q, 32);
                    if (fq == 0) P[(ai * HALF + wr * 64 + m * 16 + fr) * 4 + wc] = q; }
                asm volatile("" ::: "memory");
            }
            };
            if (md == MODE_PLE) run(std::integral_constant<int, 4>{}, std::integral_constant<bool, true>{}); else run(std::integral_constant<int, 4>{}, std::integral_constant<bool, false>{});
            asm volatile("s_waitcnt lgkmcnt(0)" ::: "memory"); __builtin_amdgcn_s_barrier(); asm volatile("" ::: "memory");
            { int t = threadIdx.x; asm volatile("" : "+v"(t));
              if (t < 256) { const f32x4 p = *(const PG8_LAS f32x4*)(P + t * 4); ((float*)(ws + (sb ? EW_ST0 : EW_ST1)))[(size_t)(u.pm * BM + t) * 4 + u.pn] = (p[0] + p[1]) + (p[2] + p[3]); } }
            return;
        }
        f32x4 svn[8]; load_sv(has_next ? nxt : u, wr, fr, svn);
#pragma unroll
        for (int ai = 0; ai < 2; ++ai)
#pragma unroll
            for (int m = 0; m < 4; ++m) {
                const int row = row0 + ai * HALF + m * 16;
                const float rs = rsv[ai * 4 + m];
                if (md == MODE_CONV_IN) {
                    if (u.pn < 8) {
                        const f32x4 v0 = (acc[ai][0][m][0] * rs) * (acc[ai][1][m][0] * rs), v1 = (acc[ai][0][m][1] * rs) * (acc[ai][1][m][1] * rs);
                        u32x4 w; w.x = cvt_pk_bf16(v0[0], v0[1]); w.y = cvt_pk_bf16(v0[2], v0[3]); w.z = cvt_pk_bf16(v1[0], v1[1]); w.w = cvt_pk_bf16(v1[2], v1[3]);
                        st16(o1, (unsigned)(row * 1024 + u.pn * 128 + cl), w);
                    } else {
#pragma unroll
                        for (int bj = 0; bj < 2; ++bj) { const f32x4 v0 = acc[ai][bj][m][0] * rs, v1 = acc[ai][bj][m][1] * rs;
                            u32x4 w; w.x = cvt_pk_bf16(v0[0], v0[1]); w.y = cvt_pk_bf16(v0[2], v0[3]); w.z = cvt_pk_bf16(v1[0], v1[1]); w.w = cvt_pk_bf16(v1[2], v1[3]);
                            st16(o0, (unsigned)(row * 1024 + (u.pn - 8) * 256 + bj * HALF + cl), w); }
                    }
                } else if (md == MODE_SG_IN) {
                    bf16_t* dstb = (u.pn < 4 ? o0 : o1);
                    float s = 0.f, q = 0.f;
#pragma unroll
                    for (int bj = 0; bj < 2; ++bj) { const f32x4 v0 = acc[ai][bj][m][0] * rs, v1 = acc[ai][bj][m][1] * rs;
                        s += ((v0[0] + v0[1]) + (v0[2] + v0[3])) + ((v1[0] + v1[1]) + (v1[2] + v1[3]));
                        q += ((v0[0] * v0[0] + v0[1] * v0[1]) + (v0[2] * v0[2] + v0[3] * v0[3])) + ((v1[0] * v1[0] + v1[1] * v1[1]) + (v1[2] * v1[2] + v1[3] * v1[3]));
                        u32x4 w; w.x = cvt_pk_bf16(v0[0], v0[1]); w.y = cvt_pk_bf16(v0[2], v0[3]); w.z = cvt_pk_bf16(v1[0], v1[1]); w.w = cvt_pk_bf16(v1[2], v1[3]);
                        st16(dstb, (unsigned)(row * 1024 + (u.pn & 3) * 256 + cl + bj * HALF), w); }
                    if (u.pn >= 4) {
                        s += __shfl_xor(s, 16); s += __shfl_xor(s, 32); q += __shfl_xor(q, 16); q += __shfl_xor(q, 32);
                        if (fq == 0) *(f32x2*)((float*)(ws + EW_VST) + ((size_t)row * 16 + (u.pn - 4) * 4 + wc) * 2) = (f32x2){s, q};
                    }
                } else if (md == MODE_FFN_UP) {
                    const f32x2 rs2 = (f32x2){rs, rs}, nl2 = (f32x2){rs * -1.4426950408889634f, rs * -1.4426950408889634f};
                    unsigned wv[4];
#pragma unroll
                    for (int n = 0; n < 2; ++n)
#pragma unroll
                        for (int h = 0; h < 2; ++h) { const f32x2 ga = (f32x2){acc[ai][0][m][n][2 * h], acc[ai][0][m][n][2 * h + 1]}, ua = (f32x2){acc[ai][1][m][n][2 * h], acc[ai][1][m][n][2 * h + 1]};
                            const f32x2 g = ga * rs2, up = ua * rs2, t = ga * nl2;
                            f32x2 e; e.x = __builtin_amdgcn_exp2f(t.x); e.y = __builtin_amdgcn_exp2f(t.y);
                            const f32x2 d = e + 1.0f; f32x2 r; r.x = __builtin_amdgcn_rcpf(d.x); r.y = __builtin_amdgcn_rcpf(d.y);
                            const f32x2 o = (g * r) * up; wv[n * 2 + h] = cvt_pk_bf16(o.x, o.y); }
                    u32x4 w; w.x = wv[0]; w.y = wv[1]; w.z = wv[2]; w.w = wv[3];
                    st16(o0, (unsigned)(row * 2816 + u.pn * 128 + cl), w);
                } else if (md == MODE_NOP) {
                } else {
                    bf16_t* po = (bf16_t*)(ws + EW_PROJ);
#pragma unroll
                    for (int bj = 0; bj < 2; ++bj) { const f32x4 v0 = acc[ai][bj][m][0], v1 = acc[ai][bj][m][1];
                        u32x4 w; w.x = cvt_pk_bf16(v0[0], v0[1]); w.y = cvt_pk_bf16(v0[2], v0[3]); w.z = cvt_pk_bf16(v1[0], v1[1]); w.w = cvt_pk_bf16(v1[2], v1[3]);
                        st16(po, (unsigned)(row * 1024 + u.pn * 256 + bj * HALF + cl), w); }
                }
            }
        reduce_sv(svn, rsv);
    }
};

#ifndef SERP_K
#define SERP_K 1
#endif
template <class Epi, class Sched, bool ALIGN_EPI = false, bool SP2 = false>
__device__ __forceinline__ void gemm_phase(PG8_LAS unsigned char* lds, const Gemm g, const Sched& S, const Epi& E) {
    int tid_ = threadIdx.x; asm volatile("" : "+v"(tid_));
    const int tid = tid_, wid = __builtin_amdgcn_readfirstlane(tid >> 6), lane = tid & 63, wr = wid >> 2, wc = wid & 3, fr = lane & 15, fq = lane >> 4;
    const int K = g.K, nt = K / BK;
    unsigned voffA[2], voffB[2];
#pragma unroll
    for (int i = 0; i < 2; ++i) { int R, C; stage_rc(tid * 16 + i * 8192, R, C); const int Rb = Epi::PERM ? ((R & ~31) + perm32(R & 31)) : R;
        voffA[i] = (unsigned)(R * K + C) * 2u; voffB[i] = (unsigned)(Rb * K + C) * 2u; }
    const size_t kstep = (size_t)(BK * 2);
    const size_t hstep = (size_t)HALF * K * 2;
    const size_t tstep = 2 * hstep;
    const unsigned ldsw = (unsigned)wid * 1024u;
    const int aoff = lds_byte(wr * 64 + fr, fq * 8), boff = lds_byte(wc * 32 + fr, fq * 8);
#define PG8_SA(b, h) (((b) * 2 + (h)) * HTB)
#define PG8_SB(b, h) ((4 + (b) * 2 + (h)) * HTB)
#define PG8_STAGE(bufoff, gbase, voff) do { _Pragma("unroll") for (int _i = 0; _i < 2; ++_i) \
        __builtin_amdgcn_global_load_lds((const unsigned*)((const char*)(gbase) + (voff)[_i]), (PG8_LAS unsigned*)(lds + (bufoff) + ldsw + _i * 8192), 16, 0, 0); } while (0)
#define PG8_LDA(dst, b, h) do { _Pragma("unroll") for (int m = 0; m < 4; ++m) _Pragma("unroll") for (int k = 0; k < 2; ++k) dst[m][k] = *(const PG8_LAS bf16x8*)(lds + PG8_SA(b, h) + aoff + m * 2048 + k * 1024); } while (0)
#define PG8_LDB(dst, b, h) do { _Pragma("unroll") for (int n = 0; n < 2; ++n) _Pragma("unroll") for (int k = 0; k < 2; ++k) dst[n][k] = *(const PG8_LAS bf16x8*)(lds + PG8_SB(b, h) + boff + n * 2048 + k * 1024); } while (0)
#define PG8_MMA(ai, bj, At, Bt) do { __builtin_amdgcn_s_setprio(1); _Pragma("unroll") for (int m = 0; m < 4; ++m) _Pragma("unroll") for (int n = 0; n < 2; ++n) _Pragma("unroll") for (int k = 0; k < 2; ++k) \
        acc[ai][bj][m][n] = __builtin_amdgcn_mfma_f32_16x16x32_bf16(Bt[n][k], At[m][k], acc[ai][bj][m][n], 0, 0, 0); __builtin_amdgcn_s_setprio(0); } while (0)
#define PG8_WAIT_V(n) asm volatile("s_waitcnt vmcnt(" #n ")" ::: "memory")
#define PG8_WAIT_L(n) asm volatile("s_waitcnt lgkmcnt(" #n ")" ::: "memory")
#define PG8_BAR __builtin_amdgcn_s_barrier()
#define PG8_SCHED __builtin_amdgcn_sched_barrier(0)
    Unit cur, nxt; int ui = 0;
    if (!S.next(0, cur)) return;
    f32x4 acc[2][2][4][2];
#pragma unroll
    for (int a = 0; a < 2; ++a)
#pragma unroll
        for (int b = 0; b < 2; ++b)
#pragma unroll
            for (int m = 0; m < 4; ++m)
#pragma unroll
                for (int n = 0; n < 2; ++n) acc[a][b][m][n] = (f32x4){0.f, 0.f, 0.f, 0.f};
    bf16x8 At[4][2], B0[2][2], B1[2][2];
    const char* cA = (const char*)g.A + (size_t)cur.pm * tstep; const char* cB = (const char*)g.Bt + (size_t)cur.pn * tstep;
    long cst = (long)kstep;
    S.a_ready(cur);
    float rsv[8];
    if (E.uses_rs()) { f32x4 sv0[8]; E.load_sv(cur, wr, fr, sv0); Epi::reduce_sv(sv0, rsv); } else {
#pragma unroll
        for (int i = 0; i < 8; ++i) rsv[i] = 1.f; }
    if constexpr (SP2) {
        PG8_STAGE(PG8_SB(0, 0), cB, voffB); PG8_STAGE(PG8_SB(0, 1), cB + hstep, voffB); PG8_STAGE(PG8_SA(0, 0), cA, voffA); PG8_STAGE(PG8_SA(0, 1), cA + hstep, voffA);
        if (wr == 1) PG8_BAR;
        PG8_WAIT_V(2); PG8_BAR;
        PG8_STAGE(PG8_SB(1, 0), cB + kstep, voffB); PG8_STAGE(PG8_SA(1, 0), cA + kstep, voffA); PG8_STAGE(PG8_SB(1, 1), cB + hstep + kstep, voffB);
        PG8_WAIT_V(6); PG8_BAR;
    } else {
        PG8_STAGE(PG8_SB(0, 0), cB, voffB); PG8_STAGE(PG8_SA(0, 0), cA, voffA); PG8_STAGE(PG8_SB(0, 1), cB + hstep, voffB); PG8_STAGE(PG8_SA(0, 1), cA + hstep, voffA);
        if (wr == 1) PG8_BAR;
        PG8_WAIT_V(4); PG8_BAR;
        PG8_STAGE(PG8_SB(1, 0), cB + kstep, voffB); PG8_STAGE(PG8_SA(1, 0), cA + kstep, voffA); PG8_STAGE(PG8_SB(1, 1), cB + hstep + kstep, voffB);
        PG8_WAIT_V(6); PG8_BAR;
    }
    for (;;) {
        const bool has_next = S.next(ui + 1, nxt);
        const bool nrev = SERP_K && has_next && (((ui + 1) & 1) != 0); const long nst = has_next ? (nrev ? -(long)kstep : (long)kstep) : cst; const size_t nk0 = nrev ? (size_t)(nt - 1) * kstep : 0;
        const char* nA = has_next ? (const char*)g.A + (size_t)nxt.pm * tstep + nk0 : cA; const char* nB = has_next ? (const char*)g.Bt + (size_t)nxt.pn * tstep + nk0 : cB;
        for (int t = 0; t < nt; t += 2) {
            const bool last = (t == nt - 2);
            const char* a1 = cA + (long)(t + 1) * cst;
            const char* a2 = last ? nA : cA + (long)(t + 2) * cst; const char* b2 = last ? nB : cB + (long)(t + 2) * cst;
            const long st3 = last ? nst : cst; const char* a3 = a2 + st3; const char* b3 = b2 + st3;
            if (last && has_next) S.a_ready(nxt);
            if constexpr (SP2) {
            PG8_LDB(B0, 0, 0); PG8_LDB(B1, 0, 1); PG8_SCHED; PG8_LDA(At, 0, 0); PG8_STAGE(PG8_SA(1, 1), a1 + hstep, voffA);
            PG8_WAIT_V(8); PG8_WAIT_L(0); PG8_BAR; PG8_MMA(0, 0, At, B0); PG8_MMA(0, 1, At, B1); PG8_BAR; PG8_SCHED;
            PG8_LDA(At, 0, 1); PG8_STAGE(PG8_SB(0, 0), b2, voffB); PG8_STAGE(PG8_SB(0, 1), b2 + hstep, voffB); PG8_STAGE(PG8_SA(0, 0), a2, voffA);
            PG8_WAIT_V(8); PG8_WAIT_L(0); PG8_BAR; PG8_MMA(1, 0, At, B0); PG8_MMA(1, 1, At, B1); PG8_BAR; PG8_SCHED;
            PG8_LDB(B0, 1, 0); PG8_LDB(B1, 1, 1); PG8_SCHED; PG8_LDA(At, 1, 0); PG8_STAGE(PG8_SA(0, 1), a2 + hstep, voffA);
            PG8_WAIT_V(8); PG8_WAIT_L(0); PG8_BAR; PG8_MMA(0, 0, At, B0); PG8_MMA(0, 1, At, B1); PG8_BAR; PG8_SCHED;
            PG8_LDA(At, 1, 1); PG8_STAGE(PG8_SB(1, 0), b3, voffB); PG8_STAGE(PG8_SB(1, 1), b3 + hstep, voffB); PG8_STAGE(PG8_SA(1, 0), a3, voffA);
            PG8_WAIT_V(8); PG8_WAIT_L(0); PG8_BAR; PG8_MMA(1, 0, At, B0); PG8_MMA(1, 1, At, B1); PG8_BAR; PG8_SCHED;
            } else {
            PG8_LDB(B0, 0, 0); PG8_SCHED; PG8_LDA(At, 0, 0); PG8_STAGE(PG8_SA(1, 1), a1 + hstep, voffA);
            PG8_WAIT_L(8); PG8_BAR; PG8_WAIT_L(0); PG8_MMA(0, 0, At, B0); PG8_BAR; PG8_SCHED;
            PG8_LDB(B1, 0, 1); PG8_STAGE(PG8_SB(0, 0), b2, voffB);
            PG8_BAR; PG8_WAIT_L(0); PG8_MMA(0, 1, At, B1); PG8_BAR;
            PG8_LDA(At, 0, 1); PG8_STAGE(PG8_SA(0, 0), a2, voffA);
            PG8_BAR; PG8_WAIT_L(0); PG8_MMA(1, 0, At, B0); PG8_BAR; PG8_SCHED;
            PG8_STAGE(PG8_SB(0, 1), b2 + hstep, voffB);
            PG8_WAIT_V(6); PG8_BAR; PG8_MMA(1, 1, At, B1); PG8_BAR;
            PG8_LDB(B0, 1, 0); PG8_SCHED; PG8_LDA(At, 1, 0); PG8_STAGE(PG8_SA(0, 1), a2 + hstep, voffA);
            PG8_WAIT_L(8); PG8_BAR; PG8_WAIT_L(0); PG8_MMA(0, 0, At, B0); PG8_BAR; PG8_SCHED;
            PG8_LDB(B1, 1, 1); PG8_STAGE(PG8_SB(1, 0), b3, voffB);
            PG8_BAR; PG8_WAIT_L(0); PG8_MMA(0, 1, At, B1); PG8_BAR;
            PG8_LDA(At, 1, 1); PG8_STAGE(PG8_SA(1, 0), a3, voffA);
            PG8_BAR; PG8_WAIT_L(0); PG8_MMA(1, 0, At, B0); PG8_BAR; PG8_SCHED;
            PG8_STAGE(PG8_SB(1, 1), b3 + hstep, voffB);
            PG8_WAIT_V(6); PG8_BAR; PG8_MMA(1, 1, At, B1); PG8_BAR;
            }
        }
        if constexpr (ALIGN_EPI) { if (wr == 0) PG8_BAR; }
        if constexpr (!Epi::AFTER_DRAIN) { int t2_ = threadIdx.x; asm volatile("" : "+v"(t2_)); const int l2_ = t2_ & 63; E(acc, cur, nxt, has_next, rsv, wr, wc, l2_ & 15, l2_ >> 4, lds); S.done(cur); }
        if (!has_next) break;
#pragma unroll
        for (int a = 0; a < 2; ++a)
#pragma unroll
            for (int b = 0; b < 2; ++b)
#pragma unroll
                for (int m = 0; m < 4; ++m)
#pragma unroll
                    for (int n = 0; n < 2; ++n) acc[a][b][m][n] = (f32x4){0.f, 0.f, 0.f, 0.f};
        cur = nxt; cA = nA; cB = nB; cst = nst; ++ui;
        if constexpr (ALIGN_EPI) { if (wr == 1) PG8_BAR; }
    }
    PG8_WAIT_V(0);
    if constexpr (!ALIGN_EPI) { if (wr == 0) PG8_BAR; }
    PG8_BAR;
    if constexpr (Epi::AFTER_DRAIN) { E.fused(acc, cur, wr, wc, fr, fq, lds, wid, lane); S.done(cur); }
#undef PG8_SA
#undef PG8_SB
#undef PG8_STAGE
#undef PG8_LDA
#undef PG8_LDB
#undef PG8_MMA
#undef PG8_WAIT_V
#undef PG8_WAIT_L
#undef PG8_BAR
#undef PG8_SCHED
}
}
constexpr int NWAVES = 8;
constexpr int BATCH = 8, SEQ = 2048, D = 1024, FF = 2816, PLE = 256, DEPTH = 4, CHUNK = 128, NGRP = 8;
constexpr int M = BATCH * SEQ;
constexpr size_t MiB = 1u << 20;
constexpr size_t WS_CTL = 0, CTL_ZERO_BYTES = 65536;
constexpr size_t WS_ST0 = 1 * MiB, WS_ST1 = 2 * MiB, WS_VST = 3 * MiB;
constexpr size_t WS_W = 5 * MiB;
constexpr size_t W_LAYER = 19 * MiB, W_GU = 0, W_DN = 11 * MiB, W_PG = 16 * MiB + MiB / 2, W_PP = 18 * MiB + MiB / 2;
constexpr size_t W_CONV = 76 * MiB, W_CONV_STRIDE = 8 * MiB, W_CIN = 0, W_COUT = 6 * MiB;
constexpr size_t W_SG = 92 * MiB, W_SG_STRIDE = 6 * MiB + MiB / 2, W_SIN = 0, W_SOUT = 4 * MiB, W_SS = 6 * MiB;
constexpr size_t WS_PB = 110 * MiB;
constexpr size_t WS_HB0 = 142 * MiB, WS_HB1 = 174 * MiB;
constexpr size_t WS_PROJ = 206 * MiB;
constexpr size_t WS_R = 238 * MiB;
constexpr size_t WS_END = 326 * MiB;
static_assert(pg8::EW_ST0 == WS_ST0 && pg8::EW_ST1 == WS_ST1 && pg8::EW_VST == WS_VST && pg8::EW_HB0 == WS_HB0 && pg8::EW_HB1 == WS_HB1 && pg8::EW_PROJ == WS_PROJ && pg8::EW_R == WS_R, "epilogue offsets vs workspace map");
#define XCD_BAR_WORDS_OFF 1024
constexpr int RING_BYTES = 131072, LDSCTL_OFF = RING_BYTES, MISC_OFF = LDSCTL_OFF + 320, LDS_BYTES = 147456;

#define GAS __attribute__((address_space(1)))
#define LAS __attribute__((address_space(3)))
typedef unsigned short bf16;
typedef unsigned v4u __attribute__((ext_vector_type(4)));
typedef unsigned v2u __attribute__((ext_vector_type(2)));
typedef float f32x4 __attribute__((ext_vector_type(4)));
typedef float f32x2 __attribute__((ext_vector_type(2)));
typedef short bf16x8 __attribute__((ext_vector_type(8)));
#define LDS_WAIT() asm volatile("s_waitcnt lgkmcnt(0)" ::: "memory")
__device__ __forceinline__ unsigned pk2(float lo, float hi) { return pg8::cvt_pk_bf16(lo, hi); }
__device__ __forceinline__ float blo(unsigned u) { return __uint_as_float(u << 16); }
__device__ __forceinline__ float bhi(unsigned u) { return __uint_as_float(u & 0xffff0000u); }

#define XB_TMO      128
#define XB_XCNT(j)  (256  + 64 * (j))
#define XB_XSUB(j)  (1280 + 64 * (j))
#define XB_XGEN(j)  (2304 + 64 * (j))
#define XB_TOP      3328
#define XB_TOPGEN   3392
#define XCD_BAR_WORDS 3456
#define XB_SPIN_CAP (1u << 18)

__device__ __forceinline__ unsigned xb_ld(unsigned* p)              { return __hip_atomic_load(p, __ATOMIC_RELAXED, __HIP_MEMORY_SCOPE_AGENT); }
__device__ __forceinline__ unsigned xb_add(unsigned* p, unsigned v) { return __hip_atomic_fetch_add(p, v, __ATOMIC_RELAXED, __HIP_MEMORY_SCOPE_AGENT); }
__device__ __forceinline__ unsigned xb_xcc_id() { return (unsigned)__builtin_amdgcn_s_getreg((3 << 11) | 20) & 0xFu; }
#define XB_SPIN(cond, bar) do { unsigned _sp = 0; while (cond) { __builtin_amdgcn_s_sleep(1); \
    if ((++_sp & 255u) == 0u) { if (xb_ld(&(bar)[XB_TMO])) break; if (_sp > XB_SPIN_CAP) { atomicAdd(&(bar)[XB_TMO], 1u); break; } } } } while (0)

struct XcdBarrier {
    unsigned* bar; unsigned x;
    volatile LAS unsigned* st;
};

__device__ __forceinline__ XcdBarrier xcd_barrier_post(unsigned* bar, volatile LAS unsigned* st) {
    XcdBarrier b; b.bar = bar; b.x = xb_xcc_id(); b.st = st;
    if (threadIdx.x == 0) (void)xb_add(&bar[XB_XCNT(b.x)], 1u);
    return b;
}
__device__ __forceinline__ void xcd_barrier_complete(unsigned* bar, unsigned x, unsigned& nloc, unsigned& nx) {
    const unsigned G = gridDim.x * gridDim.y * gridDim.z;
    unsigned sum, cnt, mine, sp = 0u;
    for (;;) {
        sum = 0u; cnt = 0u; mine = 0u;
#pragma unroll
        for (unsigned j = 0; j < 16; ++j) { const unsigned c = xb_ld(&bar[XB_XCNT(j)]); sum += c; cnt += (c > 0u) ? 1u : 0u; mine = (j == x) ? c : mine; }
        if (sum == G) break;
        __builtin_amdgcn_s_sleep(1);
        if ((++sp & 255u) == 0u) { if (xb_ld(&bar[XB_TMO])) break; if (sp > XB_SPIN_CAP) { atomicAdd(&bar[XB_TMO], 1u); break; } }
    }
    nloc = mine > 0u ? mine : 1u; nx = cnt > 0u ? cnt : 1u;
}

__device__ __forceinline__ void xcd_barrier(const XcdBarrier& b) {
    asm volatile("s_waitcnt vmcnt(0)" ::: "memory");
    __syncthreads();
    if (threadIdx.x == 0) {
        unsigned* bar = b.bar; unsigned bx = b.x; asm volatile("" : "+s"(bx));
        __builtin_amdgcn_s_waitcnt(0);
        unsigned nloc = b.st[0], nx = b.st[1];
        if (nloc == 0u) { xcd_barrier_complete(bar, bx, nloc, nx); b.st[0] = nloc; b.st[1] = nx; }
        const unsigned old = xb_add(&bar[XB_XSUB(bx)], 1u);
        const unsigned gen = old / nloc;
        if (old + 1u == (gen + 1u) * nloc) {
            __builtin_amdgcn_fence(__ATOMIC_RELEASE, "agent");
            asm volatile("s_waitcnt vmcnt(0)" ::: "memory");
            const unsigned og = xb_add(&bar[XB_TOP], 1u);
            const unsigned tg = og / nx;
            asm volatile("buffer_inv sc1" ::: "memory");
            if (og + 1u == (tg + 1u) * nx) xb_add(&bar[XB_TOPGEN], 1u);
            else XB_SPIN(xb_ld(&bar[XB_TOPGEN]) == tg, bar);
            xb_add(&bar[XB_XGEN(bx)], 1u);
            asm volatile("s_waitcnt vmcnt(0)" ::: "memory");
        } else {
            asm volatile("buffer_inv sc1" ::: "memory");
            XB_SPIN(xb_ld(&bar[XB_XGEN(bx)]) == gen, bar);
            asm volatile("s_waitcnt vmcnt(0)" ::: "memory");
        }
    }
    __syncthreads();
}
__device__ __forceinline__ float wave_sum(float v) {
#pragma unroll
    for (int o = 1; o < 64; o <<= 1) v += __shfl_xor(v, o);
    return v;
}
__device__ __forceinline__ void tr_item(const float* W, int ldw, int K, int src_col0, bf16* WT, int dst_row0, int kb, const float* gain, LAS float* scr, int lane) {
    const int k0 = 64 * kb, c4 = (lane & 7) * 4, r8 = lane >> 3;
    f32x4 v[8]; float gg[8];
#pragma unroll
    for (int i = 0; i < 8; ++i) { v[i] = __builtin_nontemporal_load((const f32x4*)(W + (size_t)(k0 + 8 * i + r8) * ldw + src_col0 + c4)); gg[i] = gain ? gain[k0 + 8 * i + r8] : 1.f; }
#pragma unroll
    for (int i = 0; i < 8; ++i) { LAS float* sp = scr + (8 * i + r8) * 33 + c4; sp[0] = v[i][0] * gg[i]; sp[1] = v[i][1] * gg[i]; sp[2] = v[i][2] * gg[i]; sp[3] = v[i][3] * gg[i]; }
    LDS_WAIT(); asm volatile("" ::: "memory");
    const int c = lane & 7;
#pragma unroll
    for (int j = 0; j < 4; ++j) { const int n = (lane >> 3) + 8 * j; const LAS float* s = scr + (8 * c) * 33 + n;
        v4u o; o.x = pk2(s[0 * 33], s[1 * 33]); o.y = pk2(s[2 * 33], s[3 * 33]); o.z = pk2(s[4 * 33], s[5 * 33]); o.w = pk2(s[6 * 33], s[7 * 33]);
        pg8::st16(WT, (unsigned)((dst_row0 + n) * K + k0 + 8 * c), o); }
    LDS_WAIT(); asm volatile("" ::: "memory");
}
struct Args { const float* in[20]; float* out; unsigned char* ws; };

__device__ __forceinline__ void prologue(const Args& a, LAS unsigned char* lds, int vcu, int G, int wave, int lane, int tid) {
    LAS float* scr = (LAS float*)(lds + wave * 16384);
    const int gw = vcu * NWAVES + wave, NGW = G * NWAVES;
    unsigned char* ws = a.ws;
    constexpr int I_GU = 16 * 176, I_DN = 44 * 32, I_PG = 16 * 32, I_PP = 4 * 32, I_CIN = 16 * 96, I_COUT = 16 * 32, I_SIN = 16 * 64, I_SOUT = 16 * 32;
    constexpr int I_COMMON = I_GU + I_DN + I_PG + I_PP, I_CONVL = I_COMMON + I_CIN + I_COUT, I_SGL = I_COMMON + I_SIN + I_SOUT, I_PAIR = I_CONVL + I_SGL;
    for (int it = gw; it < 2 * I_PAIR; it += NGW) {
        const int j = it / I_PAIR; int r = it % I_PAIR; int L = 2 * j; bool conv = true;
        if (r >= I_CONVL) { r -= I_CONVL; L += 1; conv = false; }
        unsigned char* wl = ws + WS_W + (size_t)L * W_LAYER;
        if (r < I_GU) { const int kb = r / 176, nb = r % 176, tile = nb >> 3, w = (nb & 7) * 32;
            const float* src = (w < 128 ? a.in[13] : a.in[14]) + (size_t)L * D * FF;
            tr_item(src, FF, D, tile * 128 + (w & 127), (bf16*)(wl + W_GU), nb * 32, kb, a.in[12] + L * D, scr, lane); continue; } r -= I_GU;
        if (r < I_DN) { const int kb = r / 32, nb = r % 32; tr_item(a.in[15] + (size_t)L * FF * D, D, FF, nb * 32, (bf16*)(wl + W_DN), nb * 32, kb, nullptr, scr, lane); continue; } r -= I_DN;
        if (r < I_PG) { const int kb = r / 32, nb = r % 32; tr_item(a.in[17] + (size_t)L * D * D, D, D, nb * 32, (bf16*)(wl + W_PG), nb * 32, kb, a.in[16] + L * D, scr, lane); continue; } r -= I_PG;
        if (r < I_PP) { const int kb = r / 32, nb = r % 32; tr_item(a.in[18] + (size_t)L * PLE * D, D, PLE, nb * 32, (bf16*)(wl + W_PP), nb * 32, kb, nullptr, scr, lane); continue; } r -= I_PP;
        if (conv) {
            unsigned char* wc_ = ws + WS_W + W_CONV + (size_t)j * W_CONV_STRIDE;
            if (r < I_CIN) { const int kb = r / 96, nb = r % 96, tile = nb >> 3, w = (nb & 7) * 32;
                const int sc = tile < 8 ? ((w < 128 ? 1024 : 2048) + tile * 128 + (w & 127)) : ((tile - 8) * 256 + w);
                tr_item(a.in[3] + (size_t)j * D * 3 * D, 3 * D, D, sc, (bf16*)(wc_ + W_CIN), nb * 32, kb, a.in[2] + L * D, scr, lane); continue; } r -= I_CIN;
            { const int kb = r / 32, nb = r % 32; tr_item(a.in[5] + (size_t)j * D * D, D, D, nb * 32, (bf16*)(wc_ + W_COUT), nb * 32, kb, nullptr, scr, lane); }
        } else {
            unsigned char* wsg = ws + WS_W + W_SG + (size_t)j * W_SG_STRIDE;
            if (r < I_SIN) { const int kb = r / 64, nb = r % 64; tr_item(a.in[6] + (size_t)j * D * 2 * D, 2 * D, D, nb * 32, (bf16*)(wsg + W_SIN), nb * 32, kb, a.in[2] + L * D, scr, lane); continue; } r -= I_SIN;
            { const int kb = r / 32, nb = r % 32; tr_item(a.in[11] + (size_t)j * D * D, D, D, nb * 32, (bf16*)(wsg + W_SOUT), nb * 32, kb, nullptr, scr, lane); }
        }
    }
    const int gt = vcu * NWAVES * 64 + tid, GT = G * NWAVES * 64;
    for (int i = gt; i < 2 * NGRP * CHUNK * CHUNK / 8; i += GT) {
        const int j = i / (NGRP * CHUNK * CHUNK / 8), e = (i % (NGRP * CHUNK * CHUNK / 8)) * 8, t = (e >> 7) & 127, s0 = e & 127;
        const f32x4* sp = (const f32x4*)(a.in[9] + (size_t)j * NGRP * CHUNK * CHUNK + e); f32x4 x0 = sp[0], x1 = sp[1];
        float v[8] = {x0[0], x0[1], x0[2], x0[3], x1[0], x1[1], x1[2], x1[3]};
#pragma unroll
        for (int k = 0; k < 8; ++k) if (s0 + k > t) v[k] = 0.f;
        v4u o; o.x = pk2(v[0], v[1]); o.y = pk2(v[2], v[3]); o.z = pk2(v[4], v[5]); o.w = pk2(v[6], v[7]);
        pg8::st16((bf16*)(ws + WS_W + W_SG + (size_t)j * W_SG_STRIDE + W_SS), (unsigned)e, o);
    }
    for (int i = gt; i < DEPTH * M * PLE / 8; i += 4 * GT) {
        f32x4 x0[4], x1[4];
#pragma unroll
        for (int k = 0; k < 4; ++k) { const f32x4* sp = (const f32x4*)(a.in[1] + (size_t)(i + k * GT) * 8); x0[k] = __builtin_nontemporal_load(sp); x1[k] = __builtin_nontemporal_load(sp + 1); }
#pragma unroll
        for (int k = 0; k < 4; ++k) { v4u o; o.x = pk2(x0[k][0], x0[k][1]); o.y = pk2(x0[k][2], x0[k][3]); o.z = pk2(x1[k][0], x1[k][1]); o.w = pk2(x1[k][2], x1[k][3]);
            pg8::st16((bf16*)(ws + WS_PB), (unsigned)(i + k * GT) * 8u, o); }
    }
    for (int m = gw; m < M; m += 2 * NGW) {
        f32x4 v[2][4]; float s[2];
#pragma unroll
        for (int r = 0; r < 2; ++r) { const f32x4* xr = (const f32x4*)(a.in[0] + (size_t)(m + r * NGW) * D) + lane;
#pragma unroll
            for (int k = 0; k < 4; ++k) v[r][k] = __builtin_nontemporal_load(xr + 64 * k); }
#pragma unroll
        for (int r = 0; r < 2; ++r) { s[r] = 0.f;
#pragma unroll
            for (int k = 0; k < 4; ++k) s[r] += (v[r][k][0] * v[r][k][0] + v[r][k][1] * v[r][k][1]) + (v[r][k][2] * v[r][k][2] + v[r][k][3] * v[r][k][3]);
            s[r] = wave_sum(s[r]);
            v2u* o8 = (v2u*)((bf16*)(ws + WS_HB0) + (size_t)(m + r * NGW) * D) + lane;
#pragma unroll
            for (int k = 0; k < 4; ++k) { v2u o; o.x = pk2(v[r][k][0], v[r][k][1]); o.y = pk2(v[r][k][2], v[r][k][3]); o8[64 * k] = o; }
            if (lane < 4) ((float*)(ws + WS_ST0))[(size_t)(m + r * NGW) * 4 + lane] = lane == 0 ? s[r] : 0.f; }
    }
}

__device__ __forceinline__ void conv_mid(const bf16* CX, const bf16* BG, bf16* OUT, const float* cw, int gt, int GT) {
    for (int item = gt; item < (M / 16) * 128; item += GT) {
        const int c0 = (item & 127) * 8, t0 = (item >> 7) * 16;
        float w0[8], w1[8], w2[8], p2[8], p1[8];
        { const f32x4* wp = (const f32x4*)(cw + c0); const f32x4 a0 = wp[0], a1 = wp[1], b0 = wp[256], b1 = wp[257], d0 = wp[512], d1 = wp[513];
#pragma unroll
          for (int k = 0; k < 4; ++k) { w0[k] = a0[k]; w0[4 + k] = a1[k]; w1[k] = b0[k]; w1[4 + k] = b1[k]; w2[k] = d0[k]; w2[4 + k] = d1[k]; } }
        if ((t0 & (SEQ - 1)) == 0) {
#pragma unroll
            for (int k = 0; k < 8; ++k) { p2[k] = 0.f; p1[k] = 0.f; }
        } else {
            const v4u a = *(const v4u*)(CX + (size_t)(t0 - 2) * D + c0), b = *(const v4u*)(CX + (size_t)(t0 - 1) * D + c0);
            p2[0] = blo(a.x); p2[1] = bhi(a.x); p2[2] = blo(a.y); p2[3] = bhi(a.y); p2[4] = blo(a.z); p2[5] = bhi(a.z); p2[6] = blo(a.w); p2[7] = bhi(a.w);
            p1[0] = blo(b.x); p1[1] = bhi(b.x); p1[2] = blo(b.y); p1[3] = bhi(b.y); p1[4] = blo(b.z); p1[5] = bhi(b.z); p1[6] = blo(b.w); p1[7] = bhi(b.w);
        }
#pragma unroll 16
        for (int r = 0; r < 16; ++r) {
            const size_t off = (size_t)(t0 + r) * D + c0;
            const v4u cu = *(const v4u*)(CX + off), bu = *(const v4u*)(BG + off);
            float c[8] = {blo(cu.x), bhi(cu.x), blo(cu.y), bhi(cu.y), blo(cu.z), bhi(cu.z), blo(cu.w), bhi(cu.w)};
            float b[8] = {blo(bu.x), bhi(bu.x), blo(bu.y), bhi(bu.y), blo(bu.z), bhi(bu.z), blo(bu.w), bhi(bu.w)};
            float o[8];
#pragma unroll
            for (int k = 0; k < 8; ++k) { o[k] = b[k] * (w0[k] * p2[k] + w1[k] * p1[k] + w2[k] * c[k]); p2[k] = p1[k]; p1[k] = c[k]; }
            v4u w; w.x = pk2(o[0], o[1]); w.y = pk2(o[2], o[3]); w.z = pk2(o[4], o[5]); w.w = pk2(o[6], o[7]);
            pg8::st16(OUT, (unsigned)off, w);
        }
    }
}

constexpr int VT_STRIDE = 272;
__device__ __forceinline__ void spatial_mid(const bf16* V, const bf16* U, bf16* OUT, const float* vst, const bf16* Wsb, const float* vgain, const float* vbias, const float* bsp,
                                            LAS unsigned char* lds, int vcu, int G, int wave, int lane, int tid) {
    LAS f32x2* mr = (LAS f32x2*)lds;
    LAS unsigned char* vT = lds + 1024;
    const int fr = lane & 15, fq = lane >> 4;
    for (int it = vcu; it < (M / CHUNK) * NGRP; it += G) {
        const int g = it & 7, c = it >> 3; const size_t rbase = (size_t)c * CHUNK;
        const int t0 = 16 * wave, nks = (wave >> 1) + 1;
        f32x4 sp8[8];
        if (tid < 128) { const f32x4* sp = (const f32x4*)(vst + (rbase + tid) * 32);
#pragma unroll
            for (int k = 0; k < 8; ++k) sp8[k] = sp[k]; }
        const int dc = (tid & 15) * 8;
        v4u vu[4];
#pragma unroll
        for (int k = 0; k < 4; ++k) vu[k] = *(const v4u*)(V + (rbase + ((tid + 512 * k) >> 4)) * D + g * 128 + dc);
        const f32x4* gp = (const f32x4*)(vgain + g * 128 + dc); const f32x4* bp = (const f32x4*)(vbias + g * 128 + dc);
        const f32x4 g0 = gp[0], g1 = gp[1], b0 = bp[0], b1 = bp[1];
        const bf16* wrow = Wsb + ((size_t)(g * 128 + t0 + fr)) * 128 + 8 * fq;
        bf16x8 wf[4];
#pragma unroll
        for (int ks = 0; ks < 4; ++ks) wf[ks] = *(const bf16x8*)(wrow + 32 * (ks < nks ? ks : 0));
        const float bs = bsp[g * 128 + t0 + fr];
        const bf16* urow = U + (rbase + t0 + fr) * D + g * 128 + 4 * fq; bf16* orow = OUT + (rbase + t0 + fr) * D + g * 128 + 4 * fq;
        v2u uu[8];
#pragma unroll
        for (int db = 0; db < 8; ++db) uu[db] = *(const v2u*)(urow + 16 * db);
        if (tid < 128) { float s = 0.f, q = 0.f;
#pragma unroll
            for (int k = 0; k < 8; ++k) { s += sp8[k][0] + sp8[k][2]; q += sp8[k][1] + sp8[k][3]; }
            const float mean = s * (1.0f / 1024.0f), var = fmaxf(q * (1.0f / 1024.0f) - mean * mean, 0.f);
            mr[tid] = (f32x2){mean, __builtin_amdgcn_rsqf(var + 1e-5f)};
        }
        __syncthreads();
        const float gg[8] = {g0[0], g0[1], g0[2], g0[3], g1[0], g1[1], g1[2], g1[3]}, bb[8] = {b0[0], b0[1], b0[2], b0[3], b1[0], b1[1], b1[2], b1[3]};
#pragma unroll
        for (int k = 0; k < 4; ++k) {
            const int s = (tid + 512 * k) >> 4;
            const f32x2 st = mr[s];
            const float x[8] = {blo(vu[k].x), bhi(vu[k].x), blo(vu[k].y), bhi(vu[k].y), blo(vu[k].z), bhi(vu[k].z), blo(vu[k].w), bhi(vu[k].w)};
#pragma unroll
            for (int i = 0; i < 8; ++i) { const float y = (x[i] - st.x) * st.y * gg[i] + bb[i]; const unsigned pk = pk2(y, 0.f);
                *(LAS unsigned short*)(vT + (dc + i) * VT_STRIDE + s * 2) = (unsigned short)pk; }
        }
        __syncthreads();
        pg8::f32x4 acc[8];
#pragma unroll
        for (int db = 0; db < 8; ++db) acc[db] = (pg8::f32x4){0.f, 0.f, 0.f, 0.f};
#pragma unroll
        for (int ks = 0; ks < 4; ++ks) {
            if (ks < nks) {
#pragma unroll
                for (int db = 0; db < 8; ++db) {
                    const bf16x8 vf = *(const LAS bf16x8*)(vT + (16 * db + fr) * VT_STRIDE + (32 * ks + 8 * fq) * 2);
                    acc[db] = __builtin_amdgcn_mfma_f32_16x16x32_bf16(vf, wf[ks], acc[db], 0, 0, 0);
                }
            }
        }
#pragma unroll
        for (int db = 0; db < 8; ++db) {
            v2u o; o.x = pk2(blo(uu[db].x) * (acc[db][0] + bs), bhi(uu[db].x) * (acc[db][1] + bs)); o.y = pk2(blo(uu[db].y) * (acc[db][2] + bs), bhi(uu[db].y) * (acc[db][3] + bs));
            *(v2u*)(orow + 16 * db) = o;
        }
        __syncthreads();
    }
}

__device__ __forceinline__ void final_norm(float* out, const bf16* h, const float* stats, const float* gain, int gw, int NGW, int lane) {
    f32x4 gv[4];
#pragma unroll
    for (int k = 0; k < 4; ++k) gv[k] = ((const f32x4*)gain)[lane + 64 * k];
    for (int m = gw; m < M; m += NGW) {
        const f32x4 a = *(const f32x4*)(stats + (size_t)m * 4);
        const float rs = __builtin_amdgcn_rsqf(((a[0] + a[1]) + (a[2] + a[3])) * (1.0f / 1024.0f) + 1e-6f);
        const v2u* hr = (const v2u*)(h + (size_t)m * D) + lane; f32x4* xr = (f32x4*)(out + (size_t)m * D) + lane;
        v2u hv[4];
#pragma unroll
        for (int k = 0; k < 4; ++k) hv[k] = hr[64 * k];
#pragma unroll
        for (int k = 0; k < 4; ++k) { const f32x4 v = (f32x4){blo(hv[k].x), bhi(hv[k].x), blo(hv[k].y), bhi(hv[k].y)}; xr[64 * k] = v * rs * gv[k]; }
    }
}
#ifndef STAGGER
#define STAGGER 0
#endif
#ifndef REP_G2
#define REP_G2 1
#endif
#ifndef REP_DN
#define REP_DN 1
#endif
#ifndef REP_PL
#define REP_PL 1
#endif
#ifndef REP_MID
#define REP_MID 1
#endif
#ifndef REP_PRO
#define REP_PRO 1
#endif
#ifndef REP_G1
#define REP_G1 1
#endif
#ifndef REP_UP
#define REP_UP 1
#endif
#ifndef REP_PJ
#define REP_PJ 1
#endif
__global__ void __launch_bounds__(NWAVES * 64, 2) trunk_fwd(Args args) {
    extern __shared__ __attribute__((aligned(16))) unsigned char lds_raw[];
    LAS unsigned char* lds = (LAS unsigned char*)lds_raw;
    const int tid = threadIdx.x, lane = tid & 63, wave = __builtin_amdgcn_readfirstlane(tid >> 6);
    const int G = gridDim.x; int vcu; { const int bx = blockIdx.x; vcu = (G % 8 == 0) ? (bx % 8) * (G / 8) + bx / 8 : bx; }
    unsigned char* ws = args.ws;
    for (int u = tid; u < (LDS_BYTES - LDSCTL_OFF) / 4; u += NWAVES * 64) ((LAS unsigned*)(lds + LDSCTL_OFF))[u] = 0u;
    __syncthreads();
    volatile LAS unsigned* MISC = (volatile LAS unsigned*)(lds + MISC_OFF);
    XcdBarrier bar = xcd_barrier_post((unsigned*)(ws + WS_CTL) + XCD_BAR_WORDS_OFF, MISC + 8);

    for (int rp = 0; rp < REP_PRO; ++rp) prologue(args, lds, vcu, G, wave, lane, tid);
    if (args.ws == nullptr) cg::this_grid().sync();
    xcd_barrier(bar);

    int sb = 0;
    for (int L = 0; L < DEPTH; ++L) {
        const int j = L >> 1; const bool conv = (L & 1) == 0;
        unsigned char* wl = ws + WS_W + (size_t)L * W_LAYER;
        unsigned char* wm = conv ? ws + WS_W + W_CONV + (size_t)j * W_CONV_STRIDE : ws + WS_W + W_SG + (size_t)j * W_SG_STRIDE;
        for (int s = 0; s < 7; ++s) {
            if (s == 1) {
                int tid = threadIdx.x; asm volatile("" : "+v"(tid)); const int lane = tid & 63;
                for (int rp = 0; rp < REP_MID; ++rp) {
                    bf16* mo = (bf16*)(ws + (rp + 1 < REP_MID ? WS_PROJ : WS_R));
                    if (conv) conv_mid((const bf16*)(ws + WS_R + 32 * MiB), (const bf16*)(ws + WS_R), mo, args.in[4] + (size_t)j * 3 * D, vcu * NWAVES * 64 + tid, G * NWAVES * 64);
                    else spatial_mid((const bf16*)(ws + WS_R + 32 * MiB), (const bf16*)(ws + WS_R), mo, (const float*)(ws + WS_VST), (const bf16*)(wm + W_SS),
                                     args.in[7] + (size_t)j * D, args.in[8] + (size_t)j * D, args.in[10] + (size_t)j * NGRP * CHUNK, lds, vcu, G, wave, lane, tid);
                }
            } else {
                const int rem_up = (M / 256) * (2 * FF / 256) % G;
                const int ls = (STAGGER && rem_up != 0 && (int)blockIdx.x >= rem_up && (s == 3 || s == 4)) ? 7 - s : s;
                pg8::Gemm g; pg8::Epi E;
                E.sb = sb; E.ws = ws;
                g.M = M; g.K = D; g.N = D; g.A = (const bf16*)(ws + (sb ? WS_HB1 : WS_HB0)); g.Bt = nullptr; E.mode = pg8::MODE_RES;
                bool upd = false;
                if (ls == 0) { g.Bt = (const bf16*)(wm + (conv ? W_CIN : W_SIN)); g.N = conv ? 3 * D : 2 * D; E.mode = conv ? pg8::MODE_CONV_IN : pg8::MODE_SG_IN; }
                else if (ls == 2) { g.A = (const bf16*)(ws + WS_R); g.Bt = (const bf16*)(wm + (conv ? W_COUT : W_SOUT)); E.mode = pg8::MODE_RES; upd = true; }
                else if (ls == 3) { g.Bt = (const bf16*)(wl + W_GU); g.N = 2 * FF; E.mode = pg8::MODE_FFN_UP; }
                else if (ls == 4) { g.A = (const bf16*)(ws + WS_PB) + (size_t)L * M * PLE; g.Bt = (const bf16*)(wl + W_PP); g.K = PLE; E.mode = pg8::MODE_PROJ; }
                else if (ls == 5) { g.A = (const bf16*)(ws + WS_R); g.Bt = (const bf16*)(wl + W_DN); g.K = FF; E.mode = pg8::MODE_RES; upd = true; }
                else { g.Bt = (const bf16*)(wl + W_PG); E.mode = pg8::MODE_PLE; upd = true; }
                pg8::StaticOrder S; S.init(M, g.N, G, (int)blockIdx.x);
                if (ls == 4) { const int rem = (M / 256) * (2 * FF / 256) % G;
                    if (rem != 0) { if ((int)blockIdx.x >= rem) S.init(M, g.N, G - rem, (int)blockIdx.x - rem); else S.nwg = 0; } }
                const int nrep = (ls == 0) ? REP_G1 : (ls == 3) ? REP_UP : (ls == 4) ? REP_PJ : (ls == 2) ? REP_G2 : (ls == 5) ? REP_DN : (ls == 6) ? REP_PL : 1;
                const int real_mode = E.mode;
                for (int rp = 0; rp < nrep; ++rp) { E.mode = (rp + 1 < nrep && (real_mode == pg8::MODE_RES || real_mode == pg8::MODE_PLE)) ? pg8::MODE_NOP : real_mode; pg8::gemm_phase<pg8::Epi, pg8::StaticOrder, true, true>(lds, g, S, E); }
                if (upd) sb ^= 1;
            }
            if (s != 3) xcd_barrier(bar);
        }
    }
    final_norm(args.out, (const bf16*)(ws + (sb ? WS_HB1 : WS_HB0)), (const float*)(ws + (sb ? WS_ST1 : WS_ST0)), args.in[19], vcu * NWAVES + wave, G * NWAVES, lane);
}

extern "C" void kernel_launch(void* const* d_in, const int* in_sizes, int n_in, void* d_out, int out_size, void* d_ws, size_t ws_size, hipStream_t stream) {
    static int grid = 0;
    if (grid == 0) {
        if (n_in != 20 || in_sizes[0] != M * D || out_size != M * D || ws_size < WS_END) { fprintf(stderr, "kernel_launch: unexpected shapes (n_in %d, in0 %d, out %d, ws %zu)\n", n_in, n_in > 0 ? in_sizes[0] : -1, out_size, ws_size); grid = -1; return; }
        int dev = 0, cus = 0, per_cu = 0;
        if (hipGetDevice(&dev) != hipSuccess || hipDeviceGetAttribute(&cus, hipDeviceAttributeMultiprocessorCount, dev) != hipSuccess) { grid = -1; return; }
        if (hipFuncSetAttribute((const void*)trunk_fwd, hipFuncAttributeMaxDynamicSharedMemorySize, LDS_BYTES) != hipSuccess) { fprintf(stderr, "kernel_launch: hipFuncSetAttribute failed\n"); grid = -1; return; }
        if (hipOccupancyMaxActiveBlocksPerMultiprocessor(&per_cu, (const void*)trunk_fwd, NWAVES * 64, LDS_BYTES) != hipSuccess || per_cu < 1) { fprintf(stderr, "kernel_launch: occupancy query says %d\n", per_cu); (void)hipGetLastError(); grid = -1; return; }
        grid = cus * (per_cu < 1 ? 1 : 1);
    }
    if (grid < 0) return;
    if (hipMemsetAsync((char*)d_ws + WS_CTL, 0, CTL_ZERO_BYTES, stream) != hipSuccess) return;
    Args a{};
    for (int i = 0; i < 20; ++i) a.in[i] = (const float*)d_in[i];
    a.out = (float*)d_out; a.ws = (unsigned char*)d_ws;
    void* kargs[] = {&a};
    hipError_t e = hipLaunchCooperativeKernel((const void*)trunk_fwd, dim3(grid), dim3(NWAVES * 64), kargs, LDS_BYTES, stream);
    if (e != hipSuccess) fprintf(stderr, "kernel_launch: cooperative launch failed: %s (grid %d)\n", hipGetErrorString(e), grid);
}
```

```cpp
#include <hip/hip_runtime.h>
#include <hip/hip_cooperative_groups.h>
#include <cstdio>
#include <cstdint>
#include <type_traits>
namespace cg = cooperative_groups;

namespace pg8 {
#define PG8_LAS __attribute__((address_space(3)))
typedef unsigned short bf16_t;
typedef short bf16x8 __attribute__((ext_vector_type(8)));
typedef float f32x4 __attribute__((ext_vector_type(4)));
typedef unsigned u32x4 __attribute__((ext_vector_type(4)));
constexpr int BM = 256, BK = 64, HALF = 128, HTB = HALF * BK * 2  , STAGE_BYTES = 8 * HTB, NXCD = 8, WGM = 8;

__host__ __device__ __forceinline__ int lds_byte(int r, int c) { const int st = (r >> 4) * 2 + (c >> 5), rr = r & 15, cc = c & 31, ob = rr * 64 + cc * 2; return st * 1024 + (ob ^ (((ob >> 9) & 1) << 5)); }
__host__ __device__ __forceinline__ void stage_rc(int b, int& R, int& C) { const int st = b / 1024, sb = b % 1024, swz = sb ^ (((sb >> 9) & 1) << 5); R = (st >> 1) * 16 + swz / 64; C = (st & 1) * 32 + (swz % 64) / 2; }
__host__ __device__ __forceinline__ int perm32(int rho) { const int n = rho >> 4, i = rho & 15; return 8 * (i >> 2) + 4 * n + (i & 3); }

struct Unit { int pm, pn; };
struct Gemm { const bf16_t* A; const bf16_t* Bt; int M, N, K; };

struct StaticOrder {
    int nM, nN, nwg, G, c;
    __host__ __device__ void init(int M, int N, int G_, int c_) { nM = M / BM; nN = N / BM; nwg = nM * nN; G = G_; c = c_; }
    __host__ __device__ bool next(int i, Unit& u) const {
        const long L = (long)i * G + c; if (L >= nwg) return false;
        int wgid = (int)L; { const int q = nwg / NXCD, r = nwg % NXCD, xcd = wgid % NXCD, off = wgid / NXCD; wgid = (xcd < r ? xcd * (q + 1) : r * (q + 1) + (xcd - r) * q) + off; }
        const int nig = WGM * nN, gid = wgid / nig, fm = gid * WGM, gsz = (nM - fm) < WGM ? (nM - fm) : WGM;
        u.pm = fm + ((wgid % nig) % gsz); u.pn = (wgid % nig) / gsz; return true;
    }
    __device__ __forceinline__ void a_ready(const Unit&) const {}
    __device__ __forceinline__ void done(const Unit&) const {}
};

__device__ __forceinline__ unsigned cvt_pk_bf16(float lo, float hi) { unsigned r; asm volatile("v_cvt_pk_bf16_f32 %0, %1, %2" : "=v"(r) : "v"(lo), "v"(hi)); return r; }
typedef float f32x2 __attribute__((ext_vector_type(2)));
typedef unsigned u32x2 __attribute__((ext_vector_type(2)));
enum { MODE_CONV_IN = 0, MODE_SG_IN = 1, MODE_FFN_UP = 2, MODE_RES = 3, MODE_PLE = 4, MODE_PROJ = 5, MODE_NOP = 6, MODE_CONV_B = 7 };
__device__ __forceinline__ float bflo(unsigned u) { return __uint_as_float(u << 16); }
__device__ __forceinline__ float bfhi(unsigned u) { return __uint_as_float(u & 0xffff0000u); }
__device__ __forceinline__ float sigm(float z) { return __builtin_amdgcn_rcpf(1.0f + __builtin_amdgcn_exp2f(z * -1.4426950408889634f)); }
constexpr int EPI_P_OFF = 131072 + 4096;
constexpr size_t EW_ST0 = 1u << 20, EW_ST1 = 2u << 20, EW_VST = 3u << 20, EW_HB0 = 142u << 20, EW_HB1 = 174u << 20, EW_PROJ = 206u << 20, EW_R = 238u << 20;
#ifndef EPI_GRP
#define EPI_GRP 2
#endif
#ifndef WT_STORES
#define WT_STORES 1
#endif
__device__ __forceinline__ void st16(bf16_t* base, unsigned elem_off, u32x4 w) {
#if WT_STORES
    __builtin_amdgcn_raw_buffer_store_b128(w, __builtin_amdgcn_make_buffer_rsrc(base, 0, 0x10000000, 0x00020000), elem_off * 2u, 0, 16);
#else
    *(u32x4*)(base + elem_off) = w;
#endif
}
struct Epi {
    static constexpr int GRP = EPI_GRP;
    static constexpr bool PERM = true, AFTER_DRAIN = false;
    int mode, sb;
    unsigned char* ws; const float* aux;
    __device__ __forceinline__ bool uses_rs() const { return mode == MODE_CONV_IN || mode == MODE_SG_IN || mode == MODE_FFN_UP || mode == MODE_PLE || mode == MODE_CONV_B; }
    __device__ __forceinline__ void load_sv(const Unit& u, int wr, int fr, f32x4 (&sv)[8]) const {
        const float* stats_in = (const float*)(ws + (sb ? EW_ST1 : EW_ST0)); const int row0 = u.pm * BM + wr * 64 + fr;
#pragma unroll
        for (int i = 0; i < 8; ++i) sv[i] = *(const f32x4*)(stats_in + (size_t)(row0 + (i >> 2) * HALF + (i & 3) * 16) * 4);
    }
    static __device__ __forceinline__ void reduce_sv(const f32x4 (&sv)[8], float (&rsv)[8]) {
#pragma unroll
        for (int i = 0; i < 8; ++i) rsv[i] = __builtin_amdgcn_rsqf(((sv[i][0] + sv[i][1]) + (sv[i][2] + sv[i][3])) * (1.0f / 1024.0f) + 1e-6f);
    }
    __device__ __forceinline__ void operator()(f32x4 (&acc)[2][2][4][2], const Unit& u, const Unit& nxt, bool has_next, float (&rsv)[8], int wr, int wc, int fr, int fq, PG8_LAS unsigned char* lds) const {
        const int row0 = u.pm * BM + wr * 64 + fr;
        const int cl = wc * 32 + 8 * fq;
        const int md = mode;
        bf16_t* o0 = (bf16_t*)(ws + EW_R); bf16_t* o1 = (bf16_t*)(ws + EW_R + (32u << 20));
        if (md == MODE_RES || md == MODE_PLE) {
            const bf16_t* hc = (const bf16_t*)(ws + (sb ? EW_HB1 : EW_HB0)); bf16_t* hn = (bf16_t*)(ws + (sb ? EW_HB0 : EW_HB1)); const bf16_t* proj = (const bf16_t*)(ws + EW_PROJ);
            PG8_LAS float* P = (PG8_LAS float*)(lds + EPI_P_OFF);
            auto run = [&](auto grp_c, auto ple_c) { constexpr int GRPL = decltype(grp_c)::value; constexpr bool ISPLE = decltype(ple_c)::value;
#pragma unroll
            for (int gi = 0; gi < 8; gi += GRPL) {
                u32x4 hv[GRPL][2], pv[GRPL][2];
#pragma unroll
                for (int mm = 0; mm < GRPL; ++mm)
#pragma unroll
                    for (int bj = 0; bj < 2; ++bj) { const int ai = (gi + mm) >> 2, m = (gi + mm) & 3; const size_t off = (size_t)(row0 + ai * HALF + m * 16) * 1024 + u.pn * 256 + bj * HALF + cl;
                        hv[mm][bj] = *(const u32x4*)(hc + off); if (ISPLE) pv[mm][bj] = *(const u32x4*)(proj + off); }
#pragma unroll
                for (int mm = 0; mm < GRPL; ++mm) { const int ai = (gi + mm) >> 2, m = (gi + mm) & 3; const float rs = rsv[gi + mm]; float q = 0.f;
#pragma unroll
                    for (int bj = 0; bj < 2; ++bj) { const size_t off = (size_t)(row0 + ai * HALF + m * 16) * 1024 + u.pn * 256 + bj * HALF + cl;
                        f32x4 d0 = acc[ai][bj][m][0], d1 = acc[ai][bj][m][1];
                        if (ISPLE) { const u32x4 pw = pv[mm][bj];
                            d0 = (f32x4){sigm(d0[0] * rs) * bflo(pw.x), sigm(d0[1] * rs) * bfhi(pw.x), sigm(d0[2] * rs) * bflo(pw.y), sigm(d0[3] * rs) * bfhi(pw.y)};
                            d1 = (f32x4){sigm(d1[0] * rs) * bflo(pw.z), sigm(d1[1] * rs) * bfhi(pw.z), sigm(d1[2] * rs) * bflo(pw.w), sigm(d1[3] * rs) * bfhi(pw.w)}; }
                        const u32x4 hw = hv[mm][bj];
                        const f32x4 h0 = (f32x4){bflo(hw.x), bfhi(hw.x), bflo(hw.y), bfhi(hw.y)} + d0, h1 = (f32x4){bflo(hw.z), bfhi(hw.z), bflo(hw.w), bfhi(hw.w)} + d1;
                        q += ((h0[0] * h0[0] + h0[1] * h0[1]) + (h0[2] * h0[2] + h0[3] * h0[3])) + ((h1[0] * h1[0] + h1[1] * h1[1]) + (h1[2] * h1[2] + h1[3] * h1[3]));
                        u32x4 w; w.x = cvt_pk_bf16(h0[0], h0[1]); w.y = cvt_pk_bf16(h0[2], h0[3]); w.z = cvt_pk_bf16(h1[0], h1[1]); w.w = cvt_pk_bf16(h1[2], h1[3]);
                        st16(hn, (unsigned)off, w); }
                    q += __shfl_xor(q, 16); q += __shfl_xor(q, 32);
                    if (fq == 0) P[(ai * HALF + wr * 64 + m * 16 + fr) * 4 + wc] = q; }
                asm volatile("" ::: "memory");
            }
            };
            if (md == MODE_PLE) run(std::integral_constant<int, 2>{}, std::integral_constant<bool, true>{}); else run(std::integral_constant<int, 4>{}, std::integral_constant<bool, false>{});
            asm volatile("s_waitcnt lgkmcnt(0)" ::: "memory"); __builtin_amdgcn_s_barrier(); asm volatile("" ::: "memory");
            { int t = threadIdx.x; asm volatile("" : "+v"(t));
              if (t < 256) { const f32x4 p = *(const PG8_LAS f32x4*)(P + t * 4); ((float*)(ws + (sb ? EW_ST0 : EW_ST1)))[(size_t)(u.pm * BM + t) * 4 + u.pn] = (p[0] + p[1]) + (p[2] + p[3]); } }
            return;
        }
        if (md == MODE_CONV_B) {
            const __amdgpu_buffer_rsrc_t cxr = __builtin_amdgcn_make_buffer_rsrc(ws + EW_R + (32u << 20), 0, 32 << 20, 0x00020000);
#pragma unroll
            for (int bj = 0; bj < 2; ++bj) {
                u32x4 res[8];
                int col = u.pn * 256 + bj * HALF + cl; asm volatile("" : "+v"(col));
                float w0[8], w1[8], w2[8];
                { const f32x4* wp = (const f32x4*)(aux + col); const f32x4 a0 = wp[0], a1 = wp[1], b0 = wp[256], b1 = wp[257], d0 = wp[512], d1 = wp[513];
#pragma unroll
                  for (int k = 0; k < 4; ++k) { w0[k] = a0[k]; w0[4 + k] = a1[k]; w1[k] = b0[k]; w1[4 + k] = b1[k]; w2[k] = d0[k]; w2[4 + k] = d1[k]; } }
#pragma unroll
                for (int gi = 0; gi < 8; gi += 2) {
                    u32x4 c0[2], c1[2], c2[2];
#pragma unroll
                    for (int mm = 0; mm < 2; ++mm) { const int row = row0 + ((gi + mm) >> 2) * HALF + ((gi + mm) & 3) * 16;
                        const unsigned off = (unsigned)(row * 1024 + col) * 2u;
                        c0[mm] = __builtin_amdgcn_raw_buffer_load_b128(cxr, off, 0, 0); c1[mm] = __builtin_amdgcn_raw_buffer_load_b128(cxr, off - 2048u, 0, 0); c2[mm] = __builtin_amdgcn_raw_buffer_load_b128(cxr, off - 4096u, 0, 0); }
#pragma unroll
                    for (int mm = 0; mm < 2; ++mm) { const int ai = (gi + mm) >> 2, m = (gi + mm) & 3; const int row = row0 + ai * HALF + m * 16, pos = row & 2047; const float rs = rsv[gi + mm];
                        const float k1 = pos >= 1 ? 1.f : 0.f, k2 = pos >= 2 ? 1.f : 0.f;
                        const float x0[8] = {bflo(c0[mm].x), bfhi(c0[mm].x), bflo(c0[mm].y), bfhi(c0[mm].y), bflo(c0[mm].z), bfhi(c0[mm].z), bflo(c0[mm].w), bfhi(c0[mm].w)};
                        const float x1[8] = {bflo(c1[mm].x), bfhi(c1[mm].x), bflo(c1[mm].y), bfhi(c1[mm].y), bflo(c1[mm].z), bfhi(c1[mm].z), bflo(c1[mm].w), bfhi(c1[mm].w)};
                        const float x2[8] = {bflo(c2[mm].x), bfhi(c2[mm].x), bflo(c2[mm].y), bfhi(c2[mm].y), bflo(c2[mm].z), bfhi(c2[mm].z), bflo(c2[mm].w), bfhi(c2[mm].w)};
                        float o[8];
#pragma unroll
                        for (int k = 0; k < 8; ++k) { const float b = acc[ai][bj][m][k >> 2][k & 3] * rs; o[k] = b * (w0[k] * (x2[k] * k2) + w1[k] * (x1[k] * k1) + w2[k] * x0[k]); }
                        u32x4 w; w.x = cvt_pk_bf16(o[0], o[1]); w.y = cvt_pk_bf16(o[2], o[3]); w.z = cvt_pk_bf16(o[4], o[5]); w.w = cvt_pk_bf16(o[6], o[7]); res[gi + mm] = w; }
                    asm volatile("" ::: "memory");
                }
#pragma unroll
                for (int i = 0; i < 8; ++i) st16(o0, (unsigned)((row0 + (i >> 2) * HALF + (i & 3) * 16) * 1024 + u.pn * 256 + bj * HALF + cl), res[i]);
            }
            return;
        }
        f32x4 svn[8]; load_sv(has_next ? nxt : u, wr, fr, svn);
#pragma unroll
        for (int ai = 0; ai < 2; ++ai)
#pragma unroll
            for (int m = 0; m < 4; ++m) {
                const int row = row0 + ai * HALF + m * 16;
                const float rs = rsv[ai * 4 + m];
                if (md == MODE_CONV_IN) {
                    if (u.pn < 8) {
                        const f32x4 v0 = (acc[ai][0][m][0] * rs) * (acc[ai][1][m][0] * rs), v1 = (acc[ai][0][m][1] * rs) * (acc[ai][1][m][1] * rs);
                        u32x4 w; w.x = cvt_pk_bf16(v0[0], v0[1]); w.y = cvt_pk_bf16(v0[2], v0[3]); w.z = cvt_pk_bf16(v1[0], v1[1]); w.w = cvt_pk_bf16(v1[2], v1[3]);
                        st16(o1, (unsigned)(row * 1024 + u.pn * 128 + cl), w);
                    } else {
#pragma unroll
                        for (int bj = 0; bj < 2; ++bj) { const f32x4 v0 = acc[ai][bj][m][0] * rs, v1 = acc[ai][bj][m][1] * rs;
                            u32x4 w; w.x = cvt_pk_bf16(v0[0], v0[1]); w.y = cvt_pk_bf16(v0[2], v0[3]); w.z = cvt_pk_bf16(v1[0], v1[1]); w.w = cvt_pk_bf16(v1[2], v1[3]);
                            st16(o0, (unsigned)(row * 1024 + (u.pn - 8) * 256 + bj * HALF + cl), w); }
                    }
                } else if (md == MODE_SG_IN) {
                    bf16_t* dstb = (u.pn < 4 ? o0 : o1);
                    float s = 0.f, q = 0.f;
#pragma unroll
                    for (int bj = 0; bj < 2; ++bj) { const f32x4 v0 = acc[ai][bj][m][0] * rs, v1 = acc[ai][bj][m][1] * rs;
                        s += ((v0[0] + v0[1]) + (v0[2] + v0[3])) + ((v1[0] + v1[1]) + (v1[2] + v1[3]));
                        q += ((v0[0] * v0[0] + v0[1] * v0[1]) + (v0[2] * v0[2] + v0[3] * v0[3])) + ((v1[0] * v1[0] + v1[1] * v1[1]) + (v1[2] * v1[2] + v1[3] * v1[3]));
                        u32x4 w; w.x = cvt_pk_bf16(v0[0], v0[1]); w.y = cvt_pk_bf16(v0[2], v0[3]); w.z = cvt_pk_bf16(v1[0], v1[1]); w.w = cvt_pk_bf16(v1[2], v1[3]);
                        st16(dstb, (unsigned)(row * 1024 + (u.pn & 3) * 256 + cl + bj * HALF), w); }
                    if (u.pn >= 4) {
                        s += __shfl_xor(s, 16); s += __shfl_xor(s, 32); q += __shfl_xor(q, 16); q += __shfl_xor(q, 32);
                        if (fq == 0) *(f32x2*)((float*)(ws + EW_VST) + ((size_t)row * 16 + (u.pn - 4) * 4 + wc) * 2) = (f32x2){s, q};
                    }
                } else if (md == MODE_FFN_UP) {
                    const f32x2 rs2 = (f32x2){rs, rs}, nl2 = (f32x2){rs * -1.4426950408889634f, rs * -1.4426950408889634f};
                    unsigned wv[4];
#pragma unroll
                    for (int n = 0; n < 2; ++n)
#pragma unroll
                        for (int h = 0; h < 2; ++h) { const f32x2 ga = (f32x2){acc[ai][0][m][n][2 * h], acc[ai][0][m][n][2 * h + 1]}, ua = (f32x2){acc[ai][1][m][n][2 * h], acc[ai][1][m][n][2 * h + 1]};
                            const f32x2 g = ga * rs2, up = ua * rs2, t = ga * nl2;
                            f32x2 e; e.x = __builtin_amdgcn_exp2f(t.x); e.y = __builtin_amdgcn_exp2f(t.y);
                            const f32x2 d = e + 1.0f; f32x2 r; r.x = __builtin_amdgcn_rcpf(d.x); r.y = __builtin_amdgcn_rcpf(d.y);
                            const f32x2 o = (g * r) * up; wv[n * 2 + h] = cvt_pk_bf16(o.x, o.y); }
                    u32x4 w; w.x = wv[0]; w.y = wv[1]; w.z = wv[2]; w.w = wv[3];
                    st16(o0, (unsigned)(row * 2816 + u.pn * 128 + cl), w);
                } else if (md == MODE_NOP) {
                } else {
                    bf16_t* po = (bf16_t*)(ws + EW_PROJ);
#pragma unroll
                    for (int bj = 0; bj < 2; ++bj) { const f32x4 v0 = acc[ai][bj][m][0], v1 = acc[ai][bj][m][1];
                        u32x4 w; w.x = cvt_pk_bf16(v0[0], v0[1]); w.y = cvt_pk_bf16(v0[2], v0[3]); w.z = cvt_pk_bf16(v1[0], v1[1]); w.w = cvt_pk_bf16(v1[2], v1[3]);
                        st16(po, (unsigned)(row * 1024 + u.pn * 256 + bj * HALF + cl), w); }
                }
            }
        reduce_sv(svn, rsv);
    }
};

#ifndef SERP_K
#define SERP_K 1
#endif
template <class Epi, class Sched, bool ALIGN_EPI = false, bool SP2 = false>
__device__ __forceinline__ void gemm_phase(PG8_LAS unsigned char* lds, const Gemm g, const Sched& S, const Epi& E) {
    int tid_ = threadIdx.x; asm volatile("" : "+v"(tid_));
    const int tid = tid_, wid = __builtin_amdgcn_readfirstlane(tid >> 6), lane = tid & 63, wr = wid >> 2, wc = wid & 3, fr = lane & 15, fq = lane >> 4;
    const int K = g.K, nt = K / BK;
    unsigned voffA[2], voffB[2];
#pragma unroll
    for (int i = 0; i < 2; ++i) { int R, C; stage_rc(tid * 16 + i * 8192, R, C); const int Rb = Epi::PERM ? ((R & ~31) + perm32(R & 31)) : R;
        voffA[i] = (unsigned)(R * K + C) * 2u; voffB[i] = (unsigned)(Rb * K + C) * 2u; }
    const size_t kstep = (size_t)(BK * 2);
    const size_t hstep = (size_t)HALF * K * 2;
    const size_t tstep = 2 * hstep;
    const unsigned ldsw = (unsigned)wid * 1024u;
    const int aoff = lds_byte(wr * 64 + fr, fq * 8), boff = lds_byte(wc * 32 + fr, fq * 8);
#define PG8_SA(b, h) (((b) * 2 + (h)) * HTB)
#define PG8_SB(b, h) ((4 + (b) * 2 + (h)) * HTB)
#define PG8_STAGE(bufoff, gbase, voff) do { _Pragma("unroll") for (int _i = 0; _i < 2; ++_i) \
        __builtin_amdgcn_global_load_lds((const unsigned*)((const char*)(gbase) + (voff)[_i]), (PG8_LAS unsigned*)(lds + (bufoff) + ldsw + _i * 8192), 16, 0, 0); } while (0)
#define PG8_LDA(dst, b, h) do { _Pragma("unroll") for (int m = 0; m < 4; ++m) _Pragma("unroll") for (int k = 0; k < 2; ++k) dst[m][k] = *(const PG8_LAS bf16x8*)(lds + PG8_SA(b, h) + aoff + m * 2048 + k * 1024); } while (0)
#define PG8_LDB(dst, b, h) do { _Pragma("unroll") for (int n = 0; n < 2; ++n) _Pragma("unroll") for (int k = 0; k < 2; ++k) dst[n][k] = *(const PG8_LAS bf16x8*)(lds + PG8_SB(b, h) + boff + n * 2048 + k * 1024); } while (0)
#define PG8_MMA(ai, bj, At, Bt) do { __builtin_amdgcn_s_setprio(1); _Pragma("unroll") for (int m = 0; m < 4; ++m) _Pragma("unroll") for (int n = 0; n < 2; ++n) _Pragma("unroll") for (int k = 0; k < 2; ++k) \
        acc[ai][bj][m][n] = __builtin_amdgcn_mfma_f32_16x16x32_bf16(Bt[n][k], At[m][k], acc[ai][bj][m][n], 0, 0, 0); __builtin_amdgcn_s_setprio(0); } while (0)
#define PG8_WAIT_V(n) asm volatile("s_waitcnt vmcnt(" #n ")" ::: "memory")
#define PG8_WAIT_L(n) asm volatile("s_waitcnt lgkmcnt(" #n ")" ::: "memory")
#define PG8_BAR __builtin_amdgcn_s_barrier()
#define PG8_SCHED __builtin_amdgcn_sched_barrier(0)
    Unit cur, nxt; int ui = 0;
    if (!S.next(0, cur)) return;
    f32x4 acc[2][2][4][2];
#pragma unroll
    for (int a = 0; a < 2; ++a)
#pragma unroll
        for (int b = 0; b < 2; ++b)
#pragma unroll
            for (int m = 0; m < 4; ++m)
#pragma unroll
                for (int n = 0; n < 2; ++n) acc[a][b][m][n] = (f32x4){0.f, 0.f, 0.f, 0.f};
    bf16x8 At[4][2], B0[2][2], B1[2][2];
    const char* cA = (const char*)g.A + (size_t)cur.pm * tstep; const char* cB = (const char*)g.Bt + (size_t)cur.pn * tstep;
    long cst = (long)kstep;
    S.a_ready(cur);
    float rsv[8];
    if (E.uses_rs()) { f32x4 sv0[8]; E.load_sv(cur, wr, fr, sv0); Epi::reduce_sv(sv0, rsv); } else {
#pragma unroll
        for (int i = 0; i < 8; ++i) rsv[i] = 1.f; }
    if constexpr (SP2) {
        PG8_STAGE(PG8_SB(0, 0), cB, voffB); PG8_STAGE(PG8_SB(0, 1), cB + hstep, voffB); PG8_STAGE(PG8_SA(0, 0), cA, voffA); PG8_STAGE(PG8_SA(0, 1), cA + hstep, voffA);
        if (wr == 1) PG8_BAR;
        PG8_WAIT_V(2); PG8_BAR;
        PG8_STAGE(PG8_SB(1, 0), cB + kstep, voffB); PG8_STAGE(PG8_SA(1, 0), cA + kstep, voffA); PG8_STAGE(PG8_SB(1, 1), cB + hstep + kstep, voffB);
        PG8_WAIT_V(6); PG8_BAR;
    } else {
        PG8_STAGE(PG8_SB(0, 0), cB, voffB); PG8_STAGE(PG8_SA(0, 0), cA, voffA); PG8_STAGE(PG8_SB(0, 1), cB + hstep, voffB); PG8_STAGE(PG8_SA(0, 1), cA + hstep, voffA);
        if (wr == 1) PG8_BAR;
        PG8_WAIT_V(4); PG8_BAR;
        PG8_STAGE(PG8_SB(1, 0), cB + kstep, voffB); PG8_STAGE(PG8_SA(1, 0), cA + kstep, voffA); PG8_STAGE(PG8_SB(1, 1), cB + hstep + kstep, voffB);
        PG8_WAIT_V(6); PG8_BAR;
    }
    for (;;) {
        const bool has_next = S.next(ui + 1, nxt);
        const bool nrev = SERP_K && has_next && (((ui + 1) & 1) != 0); const long nst = has_next ? (nrev ? -(long)kstep : (long)kstep) : cst; const size_t nk0 = nrev ? (size_t)(nt - 1) * kstep : 0;
        const char* nA = has_next ? (const char*)g.A + (size_t)nxt.pm * tstep + nk0 : cA; const char* nB = has_next ? (const char*)g.Bt + (size_t)nxt.pn * tstep + nk0 : cB;
        for (int t = 0; t < nt; t += 2) {
            const bool last = (t == nt - 2);
            const char* a1 = cA + (long)(t + 1) * cst;
            const char* a2 = last ? nA : cA + (long)(t + 2) * cst; const char* b2 = last ? nB : cB + (long)(t + 2) * cst;
            const long st3 = last ? nst : cst; const char* a3 = a2 + st3; const char* b3 = b2 + st3;
            if (last && has_next) S.a_ready(nxt);
            if constexpr (SP2) {
            PG8_LDB(B0, 0, 0); PG8_LDB(B1, 0, 1); PG8_SCHED; PG8_LDA(At, 0, 0); PG8_STAGE(PG8_SA(1, 1), a1 + hstep, voffA);
            PG8_WAIT_V(8); PG8_WAIT_L(0); PG8_BAR; PG8_MMA(0, 0, At, B0); PG8_MMA(0, 1, At, B1); PG8_BAR; PG8_SCHED;
            PG8_LDA(At, 0, 1); PG8_STAGE(PG8_SB(0, 0), b2, voffB); PG8_STAGE(PG8_SB(0, 1), b2 + hstep, voffB); PG8_STAGE(PG8_SA(0, 0), a2, voffA);
            PG8_WAIT_V(8); PG8_WAIT_L(0); PG8_BAR; PG8_MMA(1, 0, At, B0); PG8_MMA(1, 1, At, B1); PG8_BAR; PG8_SCHED;
            PG8_LDB(B0, 1, 0); PG8_LDB(B1, 1, 1); PG8_SCHED; PG8_LDA(At, 1, 0); PG8_STAGE(PG8_SA(0, 1), a2 + hstep, voffA);
            PG8_WAIT_V(8); PG8_WAIT_L(0); PG8_BAR; PG8_MMA(0, 0, At, B0); PG8_MMA(0, 1, At, B1); PG8_BAR; PG8_SCHED;
            PG8_LDA(At, 1, 1); PG8_STAGE(PG8_SB(1, 0), b3, voffB); PG8_STAGE(PG8_SB(1, 1), b3 + hstep, voffB); PG8_STAGE(PG8_SA(1, 0), a3, voffA);
            PG8_WAIT_V(8); PG8_WAIT_L(0); PG8_BAR; PG8_MMA(1, 0, At, B0); PG8_MMA(1, 1, At, B1); PG8_BAR; PG8_SCHED;
            } else {
            PG8_LDB(B0, 0, 0); PG8_SCHED; PG8_LDA(At, 0, 0); PG8_STAGE(PG8_SA(1, 1), a1 + hstep, voffA);
            PG8_WAIT_L(8); PG8_BAR; PG8_WAIT_L(0); PG8_MMA(0, 0, At, B0); PG8_BAR; PG8_SCHED;
            PG8_LDB(B1, 0, 1); PG8_STAGE(PG8_SB(0, 0), b2, voffB);
            PG8_BAR; PG8_WAIT_L(0); PG8_MMA(0, 1, At, B1); PG8_BAR;
            PG8_LDA(At, 0, 1); PG8_STAGE(PG8_SA(0, 0), a2, voffA);
            PG8_BAR; PG8_WAIT_L(0); PG8_MMA(1, 0, At, B0); PG8_BAR; PG8_SCHED;
            PG8_STAGE(PG8_SB(0, 1), b2 + hstep, voffB);
            PG8_WAIT_V(6); PG8_BAR; PG8_MMA(1, 1, At, B1); PG8_BAR;
            PG8_LDB(B0, 1, 0); PG8_SCHED; PG8_LDA(At, 1, 0); PG8_STAGE(PG8_SA(0, 1), a2 + hstep, voffA);
            PG8_WAIT_L(8); PG8_BAR; PG8_WAIT_L(0); PG8_MMA(0, 0, At, B0); PG8_BAR; PG8_SCHED;
            PG8_LDB(B1, 1, 1); PG8_STAGE(PG8_SB(1, 0), b3, voffB);
            PG8_BAR; PG8_WAIT_L(0); PG8_MMA(0, 1, At, B1); PG8_BAR;
            PG8_LDA(At, 1, 1); PG8_STAGE(PG8_SA(1, 0), a3, voffA);
            PG8_BAR; PG8_WAIT_L(0); PG8_MMA(1, 0, At, B0); PG8_BAR; PG8_SCHED;
            PG8_STAGE(PG8_SB(1, 1), b3 + hstep, voffB);
            PG8_WAIT_V(6); PG8_BAR; PG8_MMA(1, 1, At, B1); PG8_BAR;
            }
        }
        if constexpr (ALIGN_EPI) { if (wr == 0) PG8_BAR; }
        if constexpr (!Epi::AFTER_DRAIN) { int t2_ = threadIdx.x; asm volatile("" : "+v"(t2_)); const int l2_ = t2_ & 63; E(acc, cur, nxt, has_next, rsv, wr, wc, l2_ & 15, l2_ >> 4, lds); S.done(cur); }
        if (!has_next) break;
#pragma unroll
        for (int a = 0; a < 2; ++a)
#pragma unroll
            for (int b = 0; b < 2; ++b)
#pragma unroll
                for (int m = 0; m < 4; ++m)
#pragma unroll
                    for (int n = 0; n < 2; ++n) acc[a][b][m][n] = (f32x4){0.f, 0.f, 0.f, 0.f};
        cur = nxt; cA = nA; cB = nB; cst = nst; ++ui;
        if constexpr (ALIGN_EPI) { if (wr == 1) PG8_BAR; }
    }
    PG8_WAIT_V(0);
    if constexpr (!ALIGN_EPI) { if (wr == 0) PG8_BAR; }
    PG8_BAR;
    if constexpr (Epi::AFTER_DRAIN) { E.fused(acc, cur, wr, wc, fr, fq, lds, wid, lane); S.done(cur); }
#undef PG8_SA
#undef PG8_SB
#undef PG8_STAGE
#undef PG8_LDA
#undef PG8_LDB
#undef PG8_MMA
#undef PG8_WAIT_V
#undef PG8_WAIT_L
#undef PG8_BAR
#undef PG8_SCHED
}
}
constexpr int NWAVES = 8;
constexpr int BATCH = 8, SEQ = 2048, D = 1024, FF = 2816, PLE = 256, DEPTH = 4, CHUNK = 128, NGRP = 8;
constexpr int M = BATCH * SEQ;
constexpr size_t MiB = 1u << 20;
constexpr size_t WS_CTL = 0, CTL_ZERO_BYTES = 65536;
constexpr size_t WS_ST0 = 1 * MiB, WS_ST1 = 2 * MiB, WS_VST = 3 * MiB;
constexpr size_t WS_W = 5 * MiB;
constexpr size_t W_LAYER = 19 * MiB, W_GU = 0, W_DN = 11 * MiB, W_PG = 16 * MiB + MiB / 2, W_PP = 18 * MiB + MiB / 2;
constexpr size_t W_CONV = 76 * MiB, W_CONV_STRIDE = 8 * MiB, W_CIN = 0, W_COUT = 6 * MiB;
constexpr size_t W_SG = 92 * MiB, W_SG_STRIDE = 6 * MiB + MiB / 2, W_SIN = 0, W_SOUT = 4 * MiB, W_SS = 6 * MiB;
constexpr size_t WS_PB = 110 * MiB;
constexpr size_t WS_HB0 = 142 * MiB, WS_HB1 = 174 * MiB;
constexpr size_t WS_PROJ = 206 * MiB;
constexpr size_t WS_R = 238 * MiB;
constexpr size_t WS_END = 326 * MiB;
static_assert(pg8::EW_ST0 == WS_ST0 && pg8::EW_ST1 == WS_ST1 && pg8::EW_VST == WS_VST && pg8::EW_HB0 == WS_HB0 && pg8::EW_HB1 == WS_HB1 && pg8::EW_PROJ == WS_PROJ && pg8::EW_R == WS_R, "epilogue offsets vs workspace map");
#define XCD_BAR_WORDS_OFF 1024
constexpr int RING_BYTES = 131072, LDSCTL_OFF = RING_BYTES, MISC_OFF = LDSCTL_OFF + 320, LDS_BYTES = 147456;

#define GAS __attribute__((address_space(1)))
#define LAS __attribute__((address_space(3)))
typedef unsigned short bf16;
typedef unsigned v4u __attribute__((ext_vector_type(4)));
typedef unsigned v2u __attribute__((ext_vector_type(2)));
typedef float f32x4 __attribute__((ext_vector_type(4)));
typedef float f32x2 __attribute__((ext_vector_type(2)));
typedef short bf16x8 __attribute__((ext_vector_type(8)));
#define LDS_WAIT() asm volatile("s_waitcnt lgkmcnt(0)" ::: "memory")
__device__ __forceinline__ unsigned pk2(float lo, float hi) { return pg8::cvt_pk_bf16(lo, hi); }
__device__ __forceinline__ float blo(unsigned u) { return __uint_as_float(u << 16); }
__device__ __forceinline__ float bhi(unsigned u) { return __uint_as_float(u & 0xffff0000u); }

#define XB_TMO      128
#define XB_XCNT(j)  (256  + 64 * (j))
#define XB_XSUB(j)  (1280 + 64 * (j))
#define XB_XGEN(j)  (2304 + 64 * (j))
#define XB_TOP      3328
#define XB_TOPGEN   3392
#define XCD_BAR_WORDS 3456
#define XB_SPIN_CAP (1u << 18)

__device__ __forceinline__ unsigned xb_ld(unsigned* p)              { return __hip_atomic_load(p, __ATOMIC_RELAXED, __HIP_MEMORY_SCOPE_AGENT); }
__device__ __forceinline__ unsigned xb_add(unsigned* p, unsigned v) { return __hip_atomic_fetch_add(p, v, __ATOMIC_RELAXED, __HIP_MEMORY_SCOPE_AGENT); }
__device__ __forceinline__ unsigned xb_xcc_id() { return (unsigned)__builtin_amdgcn_s_getreg((3 << 11) | 20) & 0xFu; }
#define XB_SPIN(cond, bar) do { unsigned _sp = 0; while (cond) { __builtin_amdgcn_s_sleep(1); \
    if ((++_sp & 255u) == 0u) { if (xb_ld(&(bar)[XB_TMO])) break; if (_sp > XB_SPIN_CAP) { atomicAdd(&(bar)[XB_TMO], 1u); break; } } } } while (0)

struct XcdBarrier {
    unsigned* bar; unsigned x;
    volatile LAS unsigned* st;
};

__device__ __forceinline__ XcdBarrier xcd_barrier_post(unsigned* bar, volatile LAS unsigned* st) {
    XcdBarrier b; b.bar = bar; b.x = xb_xcc_id(); b.st = st;
    if (threadIdx.x == 0) (void)xb_add(&bar[XB_XCNT(b.x)], 1u);
    return b;
}
__device__ __forceinline__ void xcd_barrier_complete(unsigned* bar, unsigned x, unsigned& nloc, unsigned& nx) {
    const unsigned G = gridDim.x * gridDim.y * gridDim.z;
    unsigned sum, cnt, mine, sp = 0u;
    for (;;) {
        sum = 0u; cnt = 0u; mine = 0u;
#pragma unroll
        for (unsigned j = 0; j < 16; ++j) { const unsigned c = xb_ld(&bar[XB_XCNT(j)]); sum += c; cnt += (c > 0u) ? 1u : 0u; mine = (j == x) ? c : mine; }
        if (sum == G) break;
        __builtin_amdgcn_s_sleep(1);
        if ((++sp & 255u) == 0u) { if (xb_ld(&bar[XB_TMO])) break; if (sp > XB_SPIN_CAP) { atomicAdd(&bar[XB_TMO], 1u); break; } }
    }
    nloc = mine > 0u ? mine : 1u; nx = cnt > 0u ? cnt : 1u;
}

__device__ __forceinline__ void xcd_barrier(const XcdBarrier& b) {
    asm volatile("s_waitcnt vmcnt(0)" ::: "memory");
    __syncthreads();
    if (threadIdx.x == 0) {
        unsigned* bar = b.bar; unsigned bx = b.x; asm volatile("" : "+s"(bx));
        __builtin_amdgcn_s_waitcnt(0);
        unsigned nloc = b.st[0], nx = b.st[1];
        if (nloc == 0u) { xcd_barrier_complete(bar, bx, nloc, nx); b.st[0] = nloc; b.st[1] = nx; }
        const unsigned old = xb_add(&bar[XB_XSUB(bx)], 1u);
        const unsigned gen = old / nloc;
        if (old + 1u == (gen + 1u) * nloc) {
            __builtin_amdgcn_fence(__ATOMIC_RELEASE, "agent");
            asm volatile("s_waitcnt vmcnt(0)" ::: "memory");
            const unsigned og = xb_add(&bar[XB_TOP], 1u);
            const unsigned tg = og / nx;
            asm volatile("buffer_inv sc1" ::: "memory");
            if (og + 1u == (tg + 1u) * nx) xb_add(&bar[XB_TOPGEN], 1u);
            else XB_SPIN(xb_ld(&bar[XB_TOPGEN]) == tg, bar);
            xb_add(&bar[XB_XGEN(bx)], 1u);
            asm volatile("s_waitcnt vmcnt(0)" ::: "memory");
        } else {
            asm volatile("buffer_inv sc1" ::: "memory");
            XB_SPIN(xb_ld(&bar[XB_XGEN(bx)]) == gen, bar);
            asm volatile("s_waitcnt vmcnt(0)" ::: "memory");
        }
    }
    __syncthreads();
}
__device__ __forceinline__ float wave_sum(float v) {
#pragma unroll
    for (int o = 1; o < 64; o <<= 1) v += __shfl_xor(v, o);
    return v;
}
__device__ __forceinline__ void tr_item(const float* W, int ldw, int K, int src_col0, bf16* WT, int dst_row0, int kb, const float* gain, LAS float* scr, int lane) {
    const int k0 = 64 * kb, c4 = (lane & 7) * 4, r8 = lane >> 3;
    f32x4 v[8]; float gg[8];
#pragma unroll
    for (int i = 0; i < 8; ++i) { v[i] = __builtin_nontemporal_load((const f32x4*)(W + (size_t)(k0 + 8 * i + r8) * ldw + src_col0 + c4)); gg[i] = gain ? gain[k0 + 8 * i + r8] : 1.f; }
#pragma unroll
    for (int i = 0; i < 8; ++i) { LAS float* sp = scr + (8 * i + r8) * 33 + c4; sp[0] = v[i][0] * gg[i]; sp[1] = v[i][1] * gg[i]; sp[2] = v[i][2] * gg[i]; sp[3] = v[i][3] * gg[i]; }
    LDS_WAIT(); asm volatile("" ::: "memory");
    const int c = lane & 7;
#pragma unroll
    for (int j = 0; j < 4; ++j) { const int n = (lane >> 3) + 8 * j; const LAS float* s = scr + (8 * c) * 33 + n;
        v4u o; o.x = pk2(s[0 * 33], s[1 * 33]); o.y = pk2(s[2 * 33], s[3 * 33]); o.z = pk2(s[4 * 33], s[5 * 33]); o.w = pk2(s[6 * 33], s[7 * 33]);
        pg8::st16(WT, (unsigned)((dst_row0 + n) * K + k0 + 8 * c), o); }
    LDS_WAIT(); asm volatile("" ::: "memory");
}
struct Args { const float* in[20]; float* out; unsigned char* ws; };

__device__ __forceinline__ void prologue(const Args& a, LAS unsigned char* lds, int vcu, int G, int wave, int lane, int tid) {
    LAS float* scr = (LAS float*)(lds + wave * 16384);
    const int gw = vcu * NWAVES + wave, NGW = G * NWAVES;
    unsigned char* ws = a.ws;
    constexpr int I_GU = 16 * 176, I_DN = 44 * 32, I_PG = 16 * 32, I_PP = 4 * 32, I_CIN = 16 * 96, I_COUT = 16 * 32, I_SIN = 16 * 64, I_SOUT = 16 * 32;
    constexpr int I_COMMON = I_GU + I_DN + I_PG + I_PP, I_CONVL = I_COMMON + I_CIN + I_COUT, I_SGL = I_COMMON + I_SIN + I_SOUT, I_PAIR = I_CONVL + I_SGL;
    for (int it = gw; it < 2 * I_PAIR; it += NGW) {
        const int j = it / I_PAIR; int r = it % I_PAIR; int L = 2 * j; bool conv = true;
        if (r >= I_CONVL) { r -= I_CONVL; L += 1; conv = false; }
        unsigned char* wl = ws + WS_W + (size_t)L * W_LAYER;
        if (r < I_GU) { const int kb = r / 176, nb = r % 176, tile = nb >> 3, w = (nb & 7) * 32;
            const float* src = (w < 128 ? a.in[13] : a.in[14]) + (size_t)L * D * FF;
            tr_item(src, FF, D, tile * 128 + (w & 127), (bf16*)(wl + W_GU), nb * 32, kb, a.in[12] + L * D, scr, lane); continue; } r -= I_GU;
        if (r < I_DN) { const int kb = r / 32, nb = r % 32; tr_item(a.in[15] + (size_t)L * FF * D, D, FF, nb * 32, (bf16*)(wl + W_DN), nb * 32, kb, nullptr, scr, lane); continue; } r -= I_DN;
        if (r < I_PG) { const int kb = r / 32, nb = r % 32; tr_item(a.in[17] + (size_t)L * D * D, D, D, nb * 32, (bf16*)(wl + W_PG), nb * 32, kb, a.in[16] + L * D, scr, lane); continue; } r -= I_PG;
        if (r < I_PP) { const int kb = r / 32, nb = r % 32; tr_item(a.in[18] + (size_t)L * PLE * D, D, PLE, nb * 32, (bf16*)(wl + W_PP), nb * 32, kb, nullptr, scr, lane); continue; } r -= I_PP;
        if (conv) {
            unsigned char* wc_ = ws + WS_W + W_CONV + (size_t)j * W_CONV_STRIDE;
            if (r < I_CIN) { const int kb = r / 96, nb = r % 96, tile = nb >> 3, w = (nb & 7) * 32;
                const int sc = tile < 8 ? ((w < 128 ? 1024 : 2048) + tile * 128 + (w & 127)) : ((tile - 8) * 256 + w);
                tr_item(a.in[3] + (size_t)j * D * 3 * D, 3 * D, D, sc, (bf16*)(wc_ + W_CIN), nb * 32, kb, a.in[2] + L * D, scr, lane); continue; } r -= I_CIN;
            { const int kb = r / 32, nb = r % 32; tr_item(a.in[5] + (size_t)j * D * D, D, D, nb * 32, (bf16*)(wc_ + W_COUT), nb * 32, kb, nullptr, scr, lane); }
        } else {
            unsigned char* wsg = ws + WS_W + W_SG + (size_t)j * W_SG_STRIDE;
            if (r < I_SIN) { const int kb = r / 64, nb = r % 64; tr_item(a.in[6] + (size_t)j * D * 2 * D, 2 * D, D, nb * 32, (bf16*)(wsg + W_SIN), nb * 32, kb, a.in[2] + L * D, scr, lane); continue; } r -= I_SIN;
            { const int kb = r / 32, nb = r % 32; tr_item(a.in[11] + (size_t)j * D * D, D, D, nb * 32, (bf16*)(wsg + W_SOUT), nb * 32, kb, nullptr, scr, lane); }
        }
    }
    const int gt = vcu * NWAVES * 64 + tid, GT = G * NWAVES * 64;
    for (int i = gt; i < 2 * NGRP * CHUNK * CHUNK / 8; i += GT) {
        const int j = i / (NGRP * CHUNK * CHUNK / 8), e = (i % (NGRP * CHUNK * CHUNK / 8)) * 8, t = (e >> 7) & 127, s0 = e & 127;
        const f32x4* sp = (const f32x4*)(a.in[9] + (size_t)j * NGRP * CHUNK * CHUNK + e); f32x4 x0 = sp[0], x1 = sp[1];
        float v[8] = {x0[0], x0[1], x0[2], x0[3], x1[0], x1[1], x1[2], x1[3]};
#pragma unroll
        for (int k = 0; k < 8; ++k) if (s0 + k > t) v[k] = 0.f;
        v4u o; o.x = pk2(v[0], v[1]); o.y = pk2(v[2], v[3]); o.z = pk2(v[4], v[5]); o.w = pk2(v[6], v[7]);
        pg8::st16((bf16*)(ws + WS_W + W_SG + (size_t)j * W_SG_STRIDE + W_SS), (unsigned)e, o);
    }
    for (int i = gt; i < DEPTH * M * PLE / 8; i += 4 * GT) {
        f32x4 x0[4], x1[4];
#pragma unroll
        for (int k = 0; k < 4; ++k) { const f32x4* sp = (const f32x4*)(a.in[1] + (size_t)(i + k * GT) * 8); x0[k] = __builtin_nontemporal_load(sp); x1[k] = __builtin_nontemporal_load(sp + 1); }
#pragma unroll
        for (int k = 0; k < 4; ++k) { v4u o; o.x = pk2(x0[k][0], x0[k][1]); o.y = pk2(x0[k][2], x0[k][3]); o.z = pk2(x1[k][0], x1[k][1]); o.w = pk2(x1[k][2], x1[k][3]);
            pg8::st16((bf16*)(ws + WS_PB), (unsigned)(i + k * GT) * 8u, o); }
    }
    for (int m = gw; m < M; m += 2 * NGW) {
        f32x4 v[2][4]; float s[2];
#pragma unroll
        for (int r = 0; r < 2; ++r) { const f32x4* xr = (const f32x4*)(a.in[0] + (size_t)(m + r * NGW) * D) + lane;
#pragma unroll
            for (int k = 0; k < 4; ++k) v[r][k] = __builtin_nontemporal_load(xr + 64 * k); }
#pragma unroll
        for (int r = 0; r < 2; ++r) { s[r] = 0.f;
#pragma unroll
            for (int k = 0; k < 4; ++k) s[r] += (v[r][k][0] * v[r][k][0] + v[r][k][1] * v[r][k][1]) + (v[r][k][2] * v[r][k][2] + v[r][k][3] * v[r][k][3]);
            s[r] = wave_sum(s[r]);
            v2u* o8 = (v2u*)((bf16*)(ws + WS_HB0) + (size_t)(m + r * NGW) * D) + lane;
#pragma unroll
            for (int k = 0; k < 4; ++k) { v2u o; o.x = pk2(v[r][k][0], v[r][k][1]); o.y = pk2(v[r][k][2], v[r][k][3]); o8[64 * k] = o; }
            if (lane < 4) ((float*)(ws + WS_ST0))[(size_t)(m + r * NGW) * 4 + lane] = lane == 0 ? s[r] : 0.f; }
    }
}

constexpr int VT_STRIDE = 272;
__device__ __forceinline__ void spatial_mid(const bf16* V, const bf16* U, bf16* OUT, const float* vst, const bf16* Wsb, const float* vgain, const float* vbias, const float* bsp,
                                            LAS unsigned char* lds, int vcu, int G, int wave, int lane, int tid) {
    LAS f32x2* mr = (LAS f32x2*)lds;
    LAS unsigned char* vT = lds + 1024;
    const int fr = lane & 15, fq = lane >> 4;
    for (int it = vcu; it < (M / CHUNK) * NGRP; it += G) {
        const int g = it & 7, c = it >> 3; const size_t rbase = (size_t)c * CHUNK;
        const int t0 = 16 * wave, nks = (wave >> 1) + 1;
        f32x4 sp8[8];
        if (tid < 128) { const f32x4* sp = (const f32x4*)(vst + (rbase + tid) * 32);
#pragma unroll
            for (int k = 0; k < 8; ++k) sp8[k] = sp[k]; }
        const int dc = (tid & 15) * 8;
        v4u vu[4];
#pragma unroll
        for (int k = 0; k < 4; ++k) vu[k] = *(const v4u*)(V + (rbase + ((tid + 512 * k) >> 4)) * D + g * 128 + dc);
        const f32x4* gp = (const f32x4*)(vgain + g * 128 + dc); const f32x4* bp = (const f32x4*)(vbias + g * 128 + dc);
        const f32x4 g0 = gp[0], g1 = gp[1], b0 = bp[0], b1 = bp[1];
        const bf16* wrow = Wsb + ((size_t)(g * 128 + t0 + fr)) * 128 + 8 * fq;
        bf16x8 wf[4];
#pragma unroll
        for (int ks = 0; ks < 4; ++ks) wf[ks] = *(const bf16x8*)(wrow + 32 * (ks < nks ? ks : 0));
        const float bs = bsp[g * 128 + t0 + fr];
        const bf16* urow = U + (rbase + t0 + fr) * D + g * 128 + 4 * fq; bf16* orow = OUT + (rbase + t0 + fr) * D + g * 128 + 4 * fq;
        v2u uu[8];
#pragma unroll
        for (int db = 0; db < 8; ++db) uu[db] = *(const v2u*)(urow + 16 * db);
        if (tid < 128) { float s = 0.f, q = 0.f;
#pragma unroll
            for (int k = 0; k < 8; ++k) { s += sp8[k][0] + sp8[k][2]; q += sp8[k][1] + sp8[k][3]; }
            const float mean = s * (1.0f / 1024.0f), var = fmaxf(q * (1.0f / 1024.0f) - mean * mean, 0.f);
            mr[tid] = (f32x2){mean, __builtin_amdgcn_rsqf(var + 1e-5f)};
        }
        __syncthreads();
        const float gg[8] = {g0[0], g0[1], g0[2], g0[3], g1[0], g1[1], g1[2], g1[3]}, bb[8] = {b0[0], b0[1], b0[2], b0[3], b1[0], b1[1], b1[2], b1[3]};
#pragma unroll
        for (int k = 0; k < 4; ++k) {
            const int s = (tid + 512 * k) >> 4;
            const f32x2 st = mr[s];
            const float x[8] = {blo(vu[k].x), bhi(vu[k].x), blo(vu[k].y), bhi(vu[k].y), blo(vu[k].z), bhi(vu[k].z), blo(vu[k].w), bhi(vu[k].w)};
#pragma unroll
            for (int i = 0; i < 8; ++i) { const float y = (x[i] - st.x) * st.y * gg[i] + bb[i]; const unsigned pk = pk2(y, 0.f);
                *(LAS unsigned short*)(vT + (dc + i) * VT_STRIDE + s * 2) = (unsigned short)pk; }
        }
        __syncthreads();
        pg8::f32x4 acc[8];
#pragma unroll
        for (int db = 0; db < 8; ++db) acc[db] = (pg8::f32x4){0.f, 0.f, 0.f, 0.f};
#pragma unroll
        for (int ks = 0; ks < 4; ++ks) {
            if (ks < nks) {
#pragma unroll
                for (int db = 0; db < 8; ++db) {
                    const bf16x8 vf = *(const LAS bf16x8*)(vT + (16 * db + fr) * VT_STRIDE + (32 * ks + 8 * fq) * 2);
                    acc[db] = __builtin_amdgcn_mfma_f32_16x16x32_bf16(vf, wf[ks], acc[db], 0, 0, 0);
                }
            }
        }
#pragma unroll
        for (int db = 0; db < 8; ++db) {
            v2u o; o.x = pk2(blo(uu[db].x) * (acc[db][0] + bs), bhi(uu[db].x) * (acc[db][1] + bs)); o.y = pk2(blo(uu[db].y) * (acc[db][2] + bs), bhi(uu[db].y) * (acc[db][3] + bs));
            *(v2u*)(orow + 16 * db) = o;
        }
        __syncthreads();
    }
}

__device__ __forceinline__ void final_norm(float* out, const bf16* h, const float* stats, const float* gain, int gw, int NGW, int lane) {
    f32x4 gv[4];
#pragma unroll
    for (int k = 0; k < 4; ++k) gv[k] = ((const f32x4*)gain)[lane + 64 * k];
    for (int m = gw; m < M; m += NGW) {
        const f32x4 a = *(const f32x4*)(stats + (size_t)m * 4);
        const float rs = __builtin_amdgcn_rsqf(((a[0] + a[1]) + (a[2] + a[3])) * (1.0f / 1024.0f) + 1e-6f);
        const v2u* hr = (const v2u*)(h + (size_t)m * D) + lane; f32x4* xr = (f32x4*)(out + (size_t)m * D) + lane;
        v2u hv[4];
#pragma unroll
        for (int k = 0; k < 4; ++k) hv[k] = hr[64 * k];
#pragma unroll
        for (int k = 0; k < 4; ++k) { const f32x4 v = (f32x4){blo(hv[k].x), bhi(hv[k].x), blo(hv[k].y), bhi(hv[k].y)}; xr[64 * k] = v * rs * gv[k]; }
    }
}
#ifndef STAGGER
#define STAGGER 0
#endif
#ifndef REP_G2
#define REP_G2 1
#endif
#ifndef REP_DN
#define REP_DN 1
#endif
#ifndef REP_PL
#define REP_PL 1
#endif
#ifndef REP_MID
#define REP_MID 1
#endif
#ifndef REP_PRO
#define REP_PRO 1
#endif
#ifndef REP_G1
#define REP_G1 1
#endif
#ifndef REP_UP
#define REP_UP 1
#endif
#ifndef REP_PJ
#define REP_PJ 1
#endif
__global__ void __launch_bounds__(NWAVES * 64, 2) trunk_fwd(Args args) {
    extern __shared__ __attribute__((aligned(16))) unsigned char lds_raw[];
    LAS unsigned char* lds = (LAS unsigned char*)lds_raw;
    const int tid = threadIdx.x, lane = tid & 63, wave = __builtin_amdgcn_readfirstlane(tid >> 6);
    const int G = gridDim.x; int vcu; { const int bx = blockIdx.x; vcu = (G % 8 == 0) ? (bx % 8) * (G / 8) + bx / 8 : bx; }
    unsigned char* ws = args.ws;
    for (int u = tid; u < (LDS_BYTES - LDSCTL_OFF) / 4; u += NWAVES * 64) ((LAS unsigned*)(lds + LDSCTL_OFF))[u] = 0u;
    __syncthreads();
    volatile LAS unsigned* MISC = (volatile LAS unsigned*)(lds + MISC_OFF);
    XcdBarrier bar = xcd_barrier_post((unsigned*)(ws + WS_CTL) + XCD_BAR_WORDS_OFF, MISC + 8);

    for (int rp = 0; rp < REP_PRO; ++rp) prologue(args, lds, vcu, G, wave, lane, tid);
    if (args.ws == nullptr) cg::this_grid().sync();
    xcd_barrier(bar);

    int sb = 0;
    for (int L = 0; L < DEPTH; ++L) {
        const int j = L >> 1; const bool conv = (L & 1) == 0;
        unsigned char* wl = ws + WS_W + (size_t)L * W_LAYER;
        unsigned char* wm = conv ? ws + WS_W + W_CONV + (size_t)j * W_CONV_STRIDE : ws + WS_W + W_SG + (size_t)j * W_SG_STRIDE;
        for (int s = 0; s < 7; ++s) {
            if (s == 1 && !conv) {
                int tid = threadIdx.x; asm volatile("" : "+v"(tid)); const int lane = tid & 63;
                for (int rp = 0; rp < REP_MID; ++rp) {
                    bf16* mo = (bf16*)(ws + (rp + 1 < REP_MID ? WS_PROJ : WS_R));
                    spatial_mid((const bf16*)(ws + WS_R + 32 * MiB), (const bf16*)(ws + WS_R), mo, (const float*)(ws + WS_VST), (const bf16*)(wm + W_SS),
                                     args.in[7] + (size_t)j * D, args.in[8] + (size_t)j * D, args.in[10] + (size_t)j * NGRP * CHUNK, lds, vcu, G, wave, lane, tid);
                }
            } else {
                const int rem_up = (M / 256) * (2 * FF / 256) % G;
                const int ls = (STAGGER && rem_up != 0 && (int)blockIdx.x >= rem_up && (s == 3 || s == 4)) ? 7 - s : s;
                pg8::Gemm g; pg8::Epi E;
                E.sb = sb; E.ws = ws; E.aux = nullptr;
                g.M = M; g.K = D; g.N = D; g.A = (const bf16*)(ws + (sb ? WS_HB1 : WS_HB0)); g.Bt = nullptr; E.mode = pg8::MODE_RES;
                bool upd = false;
                if (ls == 0) { g.Bt = (const bf16*)(wm + (conv ? W_CIN : W_SIN)); g.N = 2 * D; E.mode = conv ? pg8::MODE_CONV_IN : pg8::MODE_SG_IN; }
                else if (ls == 1) { g.Bt = (const bf16*)(wm + W_CIN) + (size_t)2 * D * D; E.mode = pg8::MODE_CONV_B; E.aux = args.in[4] + (size_t)j * 3 * D; }
                else if (ls == 2) { g.A = (const bf16*)(ws + WS_R); g.Bt = (const bf16*)(wm + (conv ? W_COUT : W_SOUT)); E.mode = pg8::MODE_RES; upd = true; }
                else if (ls == 3) { g.Bt = (const bf16*)(wl + W_GU); g.N = 2 * FF; E.mode = pg8::MODE_FFN_UP; }
                else if (ls == 4) { g.A = (const bf16*)(ws + WS_PB) + (size_t)L * M * PLE; g.Bt = (const bf16*)(wl + W_PP); g.K = PLE; E.mode = pg8::MODE_PROJ; }
                else if (ls == 5) { g.A = (const bf16*)(ws + WS_R); g.Bt = (const bf16*)(wl + W_DN); g.K = FF; E.mode = pg8::MODE_RES; upd = true; }
                else { g.Bt = (const bf16*)(wl + W_PG); E.mode = pg8::MODE_PLE; upd = true; }
                pg8::StaticOrder S; S.init(M, g.N, G, (int)blockIdx.x);
                if (ls == 4) { const int rem = (M / 256) * (2 * FF / 256) % G;
                    if (rem != 0) { if ((int)blockIdx.x >= rem) S.init(M, g.N, G - rem, (int)blockIdx.x - rem); else S.nwg = 0; } }
                const int nrep = (ls == 0) ? REP_G1 : (ls == 3) ? REP_UP : (ls == 4) ? REP_PJ : (ls == 2) ? REP_G2 : (ls == 5) ? REP_DN : (ls == 6) ? REP_PL : 1;
                const int real_mode = E.mode;
                for (int rp = 0; rp < nrep; ++rp) { E.mode = (rp + 1 < nrep && (real_mode == pg8::MODE_RES || real_mode == pg8::MODE_PLE)) ? pg8::MODE_NOP : real_mode; pg8::gemm_phase<pg8::Epi, pg8::StaticOrder, true, true>(lds, g, S, E); }
                if (upd) sb ^= 1;
            }
            if (s != 3) xcd_barrier(bar);
        }
    }
    int tf = threadIdx.x; asm volatile("" : "+v"(tf));
    final_norm(args.out, (const bf16*)(ws + (sb ? WS_HB1 : WS_HB0)), (const float*)(ws + (sb ? WS_ST1 : WS_ST0)), args.in[19], vcu * NWAVES + (tf >> 6), G * NWAVES, tf & 63);
}

extern "C" void kernel_launch(void* const* d_in, const int* in_sizes, int n_in, void* d_out, int out_size, void* d_ws, size_t ws_size, hipStream_t stream) {
    static int grid = 0;
    if (grid == 0) {
        if (n_in != 20 || in_sizes[0] != M * D || out_size != M * D || ws_size < WS_END) { fprintf(stderr, "kernel_launch: unexpected shapes (n_in %d, in0 %d, out %d, ws %zu)\n", n_in, n_in > 0 ? in_sizes[0] : -1, out_size, ws_size); grid = -1; return; }
        int dev = 0, cus = 0, per_cu = 0;
        if (hipGetDevice(&dev) != hipSuccess || hipDeviceGetAttribute(&cus, hipDeviceAttributeMultiprocessorCount, dev) != hipSuccess) { grid = -1; return; }
        if (hipFuncSetAttribute((const void*)trunk_fwd, hipFuncAttributeMaxDynamicSharedMemorySize, LDS_BYTES) != hipSuccess) { fprintf(stderr, "kernel_launch: hipFuncSetAttribute failed\n"); grid = -1; return; }
        if (hipOccupancyMaxActiveBlocksPerMultiprocessor(&per_cu, (const void*)trunk_fwd, NWAVES * 64, LDS_BYTES) != hipSuccess || per_cu < 1) { fprintf(stderr, "kernel_launch: occupancy query says %d\n", per_cu); (void)hipGetLastError(); grid = -1; return; }
        grid = cus * (per_cu < 1 ? 1 : 1);
    }
    if (grid < 0) return;
    if (hipMemsetAsync((char*)d_ws + WS_CTL, 0, CTL_ZERO_BYTES, stream) != hipSuccess) return;
    Args a{};
    for (int i = 0; i < 20; ++i) a.in[i] = (const float*)d_in[i];
    a.out = (float*)d_out; a.ws = (unsigned char*)d_ws;
    void* kargs[] = {&a};
    hipError_t e = hipLaunchCooperativeKernel((const void*)trunk_fwd, dim3(grid), dim3(NWAVES * 64), kargs, LDS_BYTES, stream);
    if (e != hipSuccess) fprintf(stderr, "kernel_launch: cooperative launch failed: %s (grid %d)\n", hipGetErrorString(e), grid);
}
```

```cpp
#include <hip/hip_runtime.h>
#include <hip/hip_cooperative_groups.h>
#include <cstdio>
#include <cstdint>
#include <type_traits>
namespace cg = cooperative_groups;
#define PERMUTE_BLOCKS 1
namespace pg8 {
#define PG8_LAS __attribute__((address_space(3)))
typedef unsigned short bf16_t;
typedef short bf16x8 __attribute__((ext_vector_type(8)));
typedef float f32x4 __attribute__((ext_vector_type(4)));
typedef unsigned u32x4 __attribute__((ext_vector_type(4)));
constexpr int BM = 256, BK = 64, HALF = 128, HTB = HALF * BK * 2  , STAGE_BYTES = 8 * HTB, NXCD = 8, WGM = 8;

__host__ __device__ __forceinline__ int lds_byte(int r, int c) { const int st = (r >> 4) * 2 + (c >> 5), rr = r & 15, cc = c & 31, ob = rr * 64 + cc * 2; return st * 1024 + (ob ^ (((ob >> 9) & 1) << 5)); }
__host__ __device__ __forceinline__ void stage_rc(int b, int& R, int& C) { const int st = b / 1024, sb = b % 1024, swz = sb ^ (((sb >> 9) & 1) << 5); R = (st >> 1) * 16 + swz / 64; C = (st & 1) * 32 + (swz % 64) / 2; }
__host__ __device__ __forceinline__ int perm32(int rho) { const int n = rho >> 4, i = rho & 15; return 8 * (i >> 2) + 4 * n + (i & 3); }

struct Unit { int pm, pn; };
struct Gemm { const bf16_t* A; const bf16_t* Bt; int M, N, K; };

struct StaticOrder {
    int nM, nN, nwg, G, c;
    __host__ __device__ void init(int M, int N, int G_, int c_) { nM = M / BM; nN = N / BM; nwg = nM * nN; G = G_; c = c_; }
    __host__ __device__ bool next(int i, Unit& u) const {
        const long L = (long)i * G + c; if (L >= nwg) return false;
        int wgid = (int)L; { const int q = nwg / NXCD, r = nwg % NXCD, xcd = wgid % NXCD, off = wgid / NXCD; wgid = (xcd < r ? xcd * (q + 1) : r * (q + 1) + (xcd - r) * q) + off; }
        const int nig = WGM * nN, gid = wgid / nig, fm = gid * WGM, gsz = (nM - fm) < WGM ? (nM - fm) : WGM;
        u.pm = fm + ((wgid % nig) % gsz); u.pn = (wgid % nig) / gsz; return true;
    }
    __device__ __forceinline__ void a_ready(const Unit&) const {}
    __device__ __forceinline__ void done(const Unit&) const {}
};

__device__ __forceinline__ unsigned cvt_pk_bf16(float lo, float hi) { unsigned r; asm volatile("v_cvt_pk_bf16_f32 %0, %1, %2" : "=v"(r) : "v"(lo), "v"(hi)); return r; }
typedef float f32x2 __attribute__((ext_vector_type(2)));
typedef unsigned u32x2 __attribute__((ext_vector_type(2)));
enum { MODE_CONV_IN = 0, MODE_SG_IN = 1, MODE_FFN_UP = 2, MODE_RES = 3, MODE_PLE = 4, MODE_PROJ = 5, MODE_NOP = 6, MODE_CONV_B = 7 };
__device__ __forceinline__ float bflo(unsigned u) { return __uint_as_float(u << 16); }
__device__ __forceinline__ float bfhi(unsigned u) { return __uint_as_float(u & 0xffff0000u); }
__device__ __forceinline__ float sigm(float z) { return __builtin_amdgcn_rcpf(1.0f + __builtin_amdgcn_exp2f(z * -1.4426950408889634f)); }
constexpr int EPI_P_OFF = 131072 + 4096;
constexpr size_t EW_ST0 = 1u << 20, EW_ST1 = 2u << 20, EW_VST = 3u << 20, EW_HB0 = 142u << 20, EW_HB1 = 174u << 20, EW_PROJ = 206u << 20, EW_R = 238u << 20;
#ifndef EPI_GRP
#define EPI_GRP 2
#endif
#ifndef WT_STORES
#define WT_STORES 1
#endif
__device__ __forceinline__ void st16(bf16_t* base, unsigned elem_off, u32x4 w) {
#if WT_STORES
    __builtin_amdgcn_raw_buffer_store_b128(w, __builtin_amdgcn_make_buffer_rsrc(base, 0, 0x10000000, 0x00020000), elem_off * 2u, 0, 16);
#else
    *(u32x4*)(base + elem_off) = w;
#endif
}
struct Epi {
    static constexpr int GRP = EPI_GRP;
    static constexpr bool PERM = true, AFTER_DRAIN = false;
    int mode, sb;
    unsigned char* ws; const float* aux;
    __device__ __forceinline__ bool uses_rs() const { return mode == MODE_CONV_IN || mode == MODE_SG_IN || mode == MODE_FFN_UP || mode == MODE_PLE || mode == MODE_CONV_B; }
    __device__ __forceinline__ void load_sv(const Unit& u, int wr, int fr, f32x4 (&sv)[8]) const {
        const float* stats_in = (const float*)(ws + (sb ? EW_ST1 : EW_ST0)); const int row0 = u.pm * BM + wr * 64 + fr;
#pragma unroll
        for (int i = 0; i < 8; ++i) sv[i] = *(const f32x4*)(stats_in + (size_t)(row0 + (i >> 2) * HALF + (i & 3) * 16) * 4);
    }
    static __device__ __forceinline__ void reduce_sv(const f32x4 (&sv)[8], float (&rsv)[8]) {
#pragma unroll
        for (int i = 0; i < 8; ++i) rsv[i] = __builtin_amdgcn_rsqf(((sv[i][0] + sv[i][1]) + (sv[i][2] + sv[i][3])) * (1.0f / 1024.0f) + 1e-6f);
    }
    __device__ __forceinline__ void operator()(f32x4 (&acc)[2][2][4][2], const Unit& u, const Unit& nxt, bool has_next, float (&rsv)[8], int wr, int wc, int fr, int fq, PG8_LAS unsigned char* lds) const {
        const int row0 = u.pm * BM + wr * 64 + fr;
        const int cl = wc * 32 + 8 * fq;
        const int md = mode;
        bf16_t* o0 = (bf16_t*)(ws + EW_R); bf16_t* o1 = (bf16_t*)(ws + EW_R + (32u << 20));
        if (md == MODE_RES || md == MODE_PLE) {
            const bf16_t* hc = (const bf16_t*)(ws + (sb ? EW_HB1 : EW_HB0)); bf16_t* hn = (bf16_t*)(ws + (sb ? EW_HB0 : EW_HB1)); const bf16_t* proj = (const bf16_t*)(ws + EW_PROJ);
            PG8_LAS float* P = (PG8_LAS float*)(lds + EPI_P_OFF);
            auto run = [&](auto grp_c, auto ple_c) { constexpr int GRPL = decltype(grp_c)::value; constexpr bool ISPLE = decltype(ple_c)::value;
#pragma unroll
            for (int gi = 0; gi < 8; gi += GRPL) {
                u32x4 hv[GRPL][2], pv[GRPL][2];
#pragma unroll
                for (int mm = 0; mm < GRPL; ++mm)
#pragma unroll
                    for (int bj = 0; bj < 2; ++bj) { const int ai = (gi + mm) >> 2, m = (gi + mm) & 3; const size_t off = (size_t)(row0 + ai * HALF + m * 16) * 1024 + u.pn * 256 + bj * HALF + cl;
                        hv[mm][bj] = *(const u32x4*)(hc + off); if (ISPLE) pv[mm][bj] = *(const u32x4*)(proj + off); }
#pragma unroll
                for (int mm = 0; mm < GRPL; ++mm) { const int ai = (gi + mm) >> 2, m = (gi + mm) & 3; const float rs = rsv[gi + mm]; float q = 0.f;
#pragma unroll
                    for (int bj = 0; bj < 2; ++bj) { const size_t off = (size_t)(row0 + ai * HALF + m * 16) * 1024 + u.pn * 256 + bj * HALF + cl;
                        f32x4 d0 = acc[ai][bj][m][0], d1 = acc[ai][bj][m][1];
                        if (ISPLE) { const u32x4 pw = pv[mm][bj];
                            d0 = (f32x4){sigm(d0[0] * rs) * bflo(pw.x), sigm(d0[1] * rs) * bfhi(pw.x), sigm(d0[2] * rs) * bflo(pw.y), sigm(d0[3] * rs) * bfhi(pw.y)};
                            d1 = (f32x4){sigm(d1[0] * rs) * bflo(pw.z), sigm(d1[1] * rs) * bfhi(pw.z), sigm(d1[2] * rs) * bflo(pw.w), sigm(d1[3] * rs) * bfhi(pw.w)}; }
                        const u32x4 hw = hv[mm][bj];
                        const f32x4 h0 = (f32x4){bflo(hw.x), bfhi(hw.x), bflo(hw.y), bfhi(hw.y)} + d0, h1 = (f32x4){bflo(hw.z), bfhi(hw.z), bflo(hw.w), bfhi(hw.w)} + d1;
                        q += ((h0[0] * h0[0] + h0[1] * h0[1]) + (h0[2] * h0[2] + h0[3] * h0[3])) + ((h1[0] * h1[0] + h1[1] * h1[1]) + (h1[2] * h1[2] + h1[3] * h1[3]));
                        u32x4 w; w.x = cvt_pk_bf16(h0[0], h0[1]); w.y = cvt_pk_bf16(h0[2], h0[3]); w.z = cvt_pk_bf16(h1[0], h1[1]); w.w = cvt_pk_bf16(h1[2], h1[3]);
                        st16(hn, (unsigned)off, w); }
                    q += __shfl_xor(q, 16); q += __shfl_xor(q, 32);
                    if (fq == 0) P[(ai * HALF + wr * 64 + m * 16 + fr) * 4 + wc] = q; }
                asm volatile("" ::: "memory");
            }
            };
            if (md == MODE_PLE) run(std::integral_constant<int, 2>{}, std::integral_constant<bool, true>{}); else run(std::integral_constant<int, 4>{}, std::integral_constant<bool, false>{});
            asm volatile("s_waitcnt lgkmcnt(0)" ::: "memory"); __builtin_amdgcn_s_barrier(); asm volatile("" ::: "memory");
            { int t = threadIdx.x; asm volatile("" : "+v"(t));
              if (t < 256) { const f32x4 p = *(const PG8_LAS f32x4*)(P + t * 4); ((float*)(ws + (sb ? EW_ST0 : EW_ST1)))[(size_t)(u.pm * BM + t) * 4 + u.pn] = (p[0] + p[1]) + (p[2] + p[3]); } }
            return;
        }
        if (md == MODE_CONV_B) {
            const __amdgpu_buffer_rsrc_t cxr = __builtin_amdgcn_make_buffer_rsrc(ws + EW_R + (32u << 20), 0, 32 << 20, 0x00020000);
#pragma unroll
            for (int bj = 0; bj < 2; ++bj) {
                u32x4 res[8];
                int col = u.pn * 256 + bj * HALF + cl; asm volatile("" : "+v"(col));
                float w0[8], w1[8], w2[8];
                { const f32x4* wp = (const f32x4*)(aux + col); const f32x4 a0 = wp[0], a1 = wp[1], b0 = wp[256], b1 = wp[257], d0 = wp[512], d1 = wp[513];
#pragma unroll
                  for (int k = 0; k < 4; ++k) { w0[k] = a0[k]; w0[4 + k] = a1[k]; w1[k] = b0[k]; w1[4 + k] = b1[k]; w2[k] = d0[k]; w2[4 + k] = d1[k]; } }
#pragma unroll
                for (int gi = 0; gi < 8; gi += 2) {
                    u32x4 c0[2], c1[2], c2[2];
#pragma unroll
                    for (int mm = 0; mm < 2; ++mm) { const int row = row0 + ((gi + mm) >> 2) * HALF + ((gi + mm) & 3) * 16;
                        const unsigned off = (unsigned)(row * 1024 + col) * 2u;
                        c0[mm] = __builtin_amdgcn_raw_buffer_load_b128(cxr, off, 0, 0); c1[mm] = __builtin_amdgcn_raw_buffer_load_b128(cxr, off - 2048u, 0, 0); c2[mm] = __builtin_amdgcn_raw_buffer_load_b128(cxr, off - 4096u, 0, 0); }
#pragma unroll
                    for (int mm = 0; mm < 2; ++mm) { const int ai = (gi + mm) >> 2, m = (gi + mm) & 3; const int row = row0 + ai * HALF + m * 16, pos = row & 2047; const float rs = rsv[gi + mm];
                        const float k1 = pos >= 1 ? 1.f : 0.f, k2 = pos >= 2 ? 1.f : 0.f;
                        const float x0[8] = {bflo(c0[mm].x), bfhi(c0[mm].x), bflo(c0[mm].y), bfhi(c0[mm].y), bflo(c0[mm].z), bfhi(c0[mm].z), bflo(c0[mm].w), bfhi(c0[mm].w)};
                        const float x1[8] = {bflo(c1[mm].x), bfhi(c1[mm].x), bflo(c1[mm].y), bfhi(c1[mm].y), bflo(c1[mm].z), bfhi(c1[mm].z), bflo(c1[mm].w), bfhi(c1[mm].w)};
                        const float x2[8] = {bflo(c2[mm].x), bfhi(c2[mm].x), bflo(c2[mm].y), bfhi(c2[mm].y), bflo(c2[mm].z), bfhi(c2[mm].z), bflo(c2[mm].w), bfhi(c2[mm].w)};
                        float o[8];
#pragma unroll
                        for (int k = 0; k < 8; ++k) { const float b = acc[ai][bj][m][k >> 2][k & 3] * rs; o[k] = b * (w0[k] * (x2[k] * k2) + w1[k] * (x1[k] * k1) + w2[k] * x0[k]); }
                        u32x4 w; w.x = cvt_pk_bf16(o[0], o[1]); w.y = cvt_pk_bf16(o[2], o[3]); w.z = cvt_pk_bf16(o[4], o[5]); w.w = cvt_pk_bf16(o[6], o[7]); res[gi + mm] = w; }
                    asm volatile("" ::: "memory");
                }
#pragma unroll
                for (int i = 0; i < 8; ++i) st16(o0, (unsigned)((row0 + (i >> 2) * HALF + (i & 3) * 16) * 1024 + u.pn * 256 + bj * HALF + cl), res[i]);
            }
            return;
        }
        f32x4 svn[8]; load_sv(has_next ? nxt : u, wr, fr, svn);
#pragma unroll
        for (int ai = 0; ai < 2; ++ai)
#pragma unroll
            for (int m = 0; m < 4; ++m) {
                const int row = row0 + ai * HALF + m * 16;
                const float rs = rsv[ai * 4 + m];
                if (md == MODE_CONV_IN) {
                    if (u.pn < 8) {
                        const f32x4 v0 = (acc[ai][0][m][0] * rs) * (acc[ai][1][m][0] * rs), v1 = (acc[ai][0][m][1] * rs) * (acc[ai][1][m][1] * rs);
                        u32x4 w; w.x = cvt_pk_bf16(v0[0], v0[1]); w.y = cvt_pk_bf16(v0[2], v0[3]); w.z = cvt_pk_bf16(v1[0], v1[1]); w.w = cvt_pk_bf16(v1[2], v1[3]);
                        st16(o1, (unsigned)(row * 1024 + u.pn * 128 + cl), w);
                    } else {
#pragma unroll
                        for (int bj = 0; bj < 2; ++bj) { const f32x4 v0 = acc[ai][bj][m][0] * rs, v1 = acc[ai][bj][m][1] * rs;
                            u32x4 w; w.x = cvt_pk_bf16(v0[0], v0[1]); w.y = cvt_pk_bf16(v0[2], v0[3]); w.z = cvt_pk_bf16(v1[0], v1[1]); w.w = cvt_pk_bf16(v1[2], v1[3]);
                            st16(o0, (unsigned)(row * 1024 + (u.pn - 8) * 256 + bj * HALF + cl), w); }
                    }
                } else if (md == MODE_SG_IN) {
                    bf16_t* dstb = (u.pn < 4 ? o0 : o1);
                    float s = 0.f, q = 0.f;
#pragma unroll
                    for (int bj = 0; bj < 2; ++bj) { const f32x4 v0 = acc[ai][bj][m][0] * rs, v1 = acc[ai][bj][m][1] * rs;
                        s += ((v0[0] + v0[1]) + (v0[2] + v0[3])) + ((v1[0] + v1[1]) + (v1[2] + v1[3]));
                        q += ((v0[0] * v0[0] + v0[1] * v0[1]) + (v0[2] * v0[2] + v0[3] * v0[3])) + ((v1[0] * v1[0] + v1[1] * v1[1]) + (v1[2] * v1[2] + v1[3] * v1[3]));
                        u32x4 w; w.x = cvt_pk_bf16(v0[0], v0[1]); w.y = cvt_pk_bf16(v0[2], v0[3]); w.z = cvt_pk_bf16(v1[0], v1[1]); w.w = cvt_pk_bf16(v1[2], v1[3]);
                        st16(dstb, (unsigned)(row * 1024 + (u.pn & 3) * 256 + cl + bj * HALF), w); }
                    if (u.pn >= 4) {
                        s += __shfl_xor(s, 16); s += __shfl_xor(s, 32); q += __shfl_xor(q, 16); q += __shfl_xor(q, 32);
                        if (fq == 0) *(f32x2*)((float*)(ws + EW_VST) + ((size_t)row * 16 + (u.pn - 4) * 4 + wc) * 2) = (f32x2){s, q};
                    }
                } else if (md == MODE_FFN_UP) {
                    const f32x2 rs2 = (f32x2){rs, rs}, nl2 = (f32x2){rs * -1.4426950408889634f, rs * -1.4426950408889634f};
                    unsigned wv[4];
#pragma unroll
                    for (int n = 0; n < 2; ++n)
#pragma unroll
                        for (int h = 0; h < 2; ++h) { const f32x2 ga = (f32x2){acc[ai][0][m][n][2 * h], acc[ai][0][m][n][2 * h + 1]}, ua = (f32x2){acc[ai][1][m][n][2 * h], acc[ai][1][m][n][2 * h + 1]};
                            const f32x2 g = ga * rs2, up = ua * rs2, t = ga * nl2;
                            f32x2 e; e.x = __builtin_amdgcn_exp2f(t.x); e.y = __builtin_amdgcn_exp2f(t.y);
                            const f32x2 d = e + 1.0f; f32x2 r; r.x = __builtin_amdgcn_rcpf(d.x); r.y = __builtin_amdgcn_rcpf(d.y);
                            const f32x2 o = (g * r) * up; wv[n * 2 + h] = cvt_pk_bf16(o.x, o.y); }
                    u32x4 w; w.x = wv[0]; w.y = wv[1]; w.z = wv[2]; w.w = wv[3];
                    st16(o0, (unsigned)(row * 2816 + u.pn * 128 + cl), w);
                } else if (md == MODE_NOP) {
                } else {
                    bf16_t* po = (bf16_t*)(ws + EW_PROJ);
#pragma unroll
                    for (int bj = 0; bj < 2; ++bj) { const f32x4 v0 = acc[ai][bj][m][0], v1 = acc[ai][bj][m][1];
                        u32x4 w; w.x = cvt_pk_bf16(v0[0], v0[1]); w.y = cvt_pk_bf16(v0[2], v0[3]); w.z = cvt_pk_bf16(v1[0], v1[1]); w.w = cvt_pk_bf16(v1[2], v1[3]);
                        st16(po, (unsigned)(row * 1024 + u.pn * 256 + bj * HALF + cl), w); }
                }
            }
        reduce_sv(svn, rsv);
    }
};

#ifndef SERP_K
#define SERP_K 1
#endif
template <class Epi, class Sched, bool ALIGN_EPI = false, bool SP2 = false>
__device__ __forceinline__ void gemm_phase(PG8_LAS unsigned char* lds, const Gemm g, const Sched& S, const Epi& E) {
    int tid_ = threadIdx.x; asm volatile("" : "+v"(tid_));
    const int tid = tid_, wid = __builtin_amdgcn_readfirstlane(tid >> 6), lane = tid & 63, wr = wid >> 2, wc = wid & 3, fr = lane & 15, fq = lane >> 4;
    const int K = g.K, nt = K / BK;
    unsigned voffA[2], voffB[2];
#pragma unroll
    for (int i = 0; i < 2; ++i) { int R, C; stage_rc(tid * 16 + i * 8192, R, C); const int Rb = Epi::PERM ? ((R & ~31) + perm32(R & 31)) : R;
        voffA[i] = (unsigned)(R * K + C) * 2u; voffB[i] = (unsigned)(Rb * K + C) * 2u; }
    const size_t kstep = (size_t)(BK * 2);
    const size_t hstep = (size_t)HALF * K * 2;
    const size_t tstep = 2 * hstep;
    const unsigned ldsw = (unsigned)wid * 1024u;
    const int aoff = lds_byte(wr * 64 + fr, fq * 8), boff = lds_byte(wc * 32 + fr, fq * 8);
#define PG8_SA(b, h) (((b) * 2 + (h)) * HTB)
#define PG8_SB(b, h) ((4 + (b) * 2 + (h)) * HTB)
#define PG8_STAGE(bufoff, gbase, voff) do { _Pragma("unroll") for (int _i = 0; _i < 2; ++_i) \
        __builtin_amdgcn_global_load_lds((const unsigned*)((const char*)(gbase) + (voff)[_i]), (PG8_LAS unsigned*)(lds + (bufoff) + ldsw + _i * 8192), 16, 0, 0); } while (0)
#define PG8_LDA(dst, b, h) do { _Pragma("unroll") for (int m = 0; m < 4; ++m) _Pragma("unroll") for (int k = 0; k < 2; ++k) dst[m][k] = *(const PG8_LAS bf16x8*)(lds + PG8_SA(b, h) + aoff + m * 2048 + k * 1024); } while (0)
#define PG8_LDB(dst, b, h) do { _Pragma("unroll") for (int n = 0; n < 2; ++n) _Pragma("unroll") for (int k = 0; k < 2; ++k) dst[n][k] = *(const PG8_LAS bf16x8*)(lds + PG8_SB(b, h) + boff + n * 2048 + k * 1024); } while (0)
#define PG8_MMA(ai, bj, At, Bt) do { __builtin_amdgcn_s_setprio(1); _Pragma("unroll") for (int m = 0; m < 4; ++m) _Pragma("unroll") for (int n = 0; n < 2; ++n) _Pragma("unroll") for (int k = 0; k < 2; ++k) \
        acc[ai][bj][m][n] = __builtin_amdgcn_mfma_f32_16x16x32_bf16(Bt[n][k], At[m][k], acc[ai][bj][m][n], 0, 0, 0); __builtin_amdgcn_s_setprio(0); } while (0)
#define PG8_WAIT_V(n) asm volatile("s_waitcnt vmcnt(" #n ")" ::: "memory")
#define PG8_WAIT_L(n) asm volatile("s_waitcnt lgkmcnt(" #n ")" ::: "memory")
#define PG8_BAR __builtin_amdgcn_s_barrier()
#define PG8_SCHED __builtin_amdgcn_sched_barrier(0)
    Unit cur, nxt; int ui = 0;
    if (!S.next(0, cur)) return;
    f32x4 acc[2][2][4][2];
#pragma unroll
    for (int a = 0; a < 2; ++a)
#pragma unroll
        for (int b = 0; b < 2; ++b)
#pragma unroll
            for (int m = 0; m < 4; ++m)
#pragma unroll
                for (int n = 0; n < 2; ++n) acc[a][b][m][n] = (f32x4){0.f, 0.f, 0.f, 0.f};
    bf16x8 At[4][2], B0[2][2], B1[2][2];
    const char* cA = (const char*)g.A + (size_t)cur.pm * tstep; const char* cB = (const char*)g.Bt + (size_t)cur.pn * tstep;
    long cst = (long)kstep;
    S.a_ready(cur);
    float rsv[8];
    if (E.uses_rs()) { f32x4 sv0[8]; E.load_sv(cur, wr, fr, sv0); Epi::reduce_sv(sv0, rsv); } else {
#pragma unroll
        for (int i = 0; i < 8; ++i) rsv[i] = 1.f; }
    if constexpr (SP2) {
        PG8_STAGE(PG8_SB(0, 0), cB, voffB); PG8_STAGE(PG8_SB(0, 1), cB + hstep, voffB); PG8_STAGE(PG8_SA(0, 0), cA, voffA); PG8_STAGE(PG8_SA(0, 1), cA + hstep, voffA);
        if (wr == 1) PG8_BAR;
        PG8_WAIT_V(2); PG8_BAR;
        PG8_STAGE(PG8_SB(1, 0), cB + kstep, voffB); PG8_STAGE(PG8_SA(1, 0), cA + kstep, voffA); PG8_STAGE(PG8_SB(1, 1), cB + hstep + kstep, voffB);
        PG8_WAIT_V(6); PG8_BAR;
    } else {
        PG8_STAGE(PG8_SB(0, 0), cB, voffB); PG8_STAGE(PG8_SA(0, 0), cA, voffA); PG8_STAGE(PG8_SB(0, 1), cB + hstep, voffB); PG8_STAGE(PG8_SA(0, 1), cA + hstep, voffA);
        if (wr == 1) PG8_BAR;
        PG8_WAIT_V(4); PG8_BAR;
        PG8_STAGE(PG8_SB(1, 0), cB + kstep, voffB); PG8_STAGE(PG8_SA(1, 0), cA + kstep, voffA); PG8_STAGE(PG8_SB(1, 1), cB + hstep + kstep, voffB);
        PG8_WAIT_V(6); PG8_BAR;
    }
    for (;;) {
        const bool has_next = S.next(ui + 1, nxt);
        const bool nrev = SERP_K && has_next && (((ui + 1) & 1) != 0); const long nst = has_next ? (nrev ? -(long)kstep : (long)kstep) : cst; const size_t nk0 = nrev ? (size_t)(nt - 1) * kstep : 0;
        const char* nA = has_next ? (const char*)g.A + (size_t)nxt.pm * tstep + nk0 : cA; const char* nB = has_next ? (const char*)g.Bt + (size_t)nxt.pn * tstep + nk0 : cB;
        for (int t = 0; t < nt; t += 2) {
            const bool last = (t == nt - 2);
            const char* a1 = cA + (long)(t + 1) * cst;
            const char* a2 = last ? nA : cA + (long)(t + 2) * cst; const char* b2 = last ? nB : cB + (long)(t + 2) * cst;
            const long st3 = last ? nst : cst; const char* a3 = a2 + st3; const char* b3 = b2 + st3;
            if (last && has_next) S.a_ready(nxt);
            if constexpr (SP2) {
            PG8_LDB(B0, 0, 0); PG8_LDB(B1, 0, 1); PG8_SCHED; PG8_LDA(At, 0, 0); PG8_STAGE(PG8_SA(1, 1), a1 + hstep, voffA);
            PG8_WAIT_V(8); PG8_WAIT_L(0); PG8_BAR; PG8_MMA(0, 0, At, B0); PG8_MMA(0, 1, At, B1); PG8_BAR; PG8_SCHED;
            PG8_LDA(At, 0, 1); PG8_STAGE(PG8_SB(0, 0), b2, voffB); PG8_STAGE(PG8_SB(0, 1), b2 + hstep, voffB); PG8_STAGE(PG8_SA(0, 0), a2, voffA);
            PG8_WAIT_V(8); PG8_WAIT_L(0); PG8_BAR; PG8_MMA(1, 0, At, B0); PG8_MMA(1, 1, At, B1); PG8_BAR; PG8_SCHED;
            PG8_LDB(B0, 1, 0); PG8_LDB(B1, 1, 1); PG8_SCHED; PG8_LDA(At, 1, 0); PG8_STAGE(PG8_SA(0, 1), a2 + hstep, voffA);
            PG8_WAIT_V(8); PG8_WAIT_L(0); PG8_BAR; PG8_MMA(0, 0, At, B0); PG8_MMA(0, 1, At, B1); PG8_BAR; PG8_SCHED;
            PG8_LDA(At, 1, 1); PG8_STAGE(PG8_SB(1, 0), b3, voffB); PG8_STAGE(PG8_SB(1, 1), b3 + hstep, voffB); PG8_STAGE(PG8_SA(1, 0), a3, voffA);
            PG8_WAIT_V(8); PG8_WAIT_L(0); PG8_BAR; PG8_MMA(1, 0, At, B0); PG8_MMA(1, 1, At, B1); PG8_BAR; PG8_SCHED;
            } else {
            PG8_LDB(B0, 0, 0); PG8_SCHED; PG8_LDA(At, 0, 0); PG8_STAGE(PG8_SA(1, 1), a1 + hstep, voffA);
            PG8_WAIT_L(8); PG8_BAR; PG8_WAIT_L(0); PG8_MMA(0, 0, At, B0); PG8_BAR; PG8_SCHED;
            PG8_LDB(B1, 0, 1); PG8_STAGE(PG8_SB(0, 0), b2, voffB);
            PG8_BAR; PG8_WAIT_L(0); PG8_MMA(0, 1, At, B1); PG8_BAR;
            PG8_LDA(At, 0, 1); PG8_STAGE(PG8_SA(0, 0), a2, voffA);
            PG8_BAR; PG8_WAIT_L(0); PG8_MMA(1, 0, At, B0); PG8_BAR; PG8_SCHED;
            PG8_STAGE(PG8_SB(0, 1), b2 + hstep, voffB);
            PG8_WAIT_V(6); PG8_BAR; PG8_MMA(1, 1, At, B1); PG8_BAR;
            PG8_LDB(B0, 1, 0); PG8_SCHED; PG8_LDA(At, 1, 0); PG8_STAGE(PG8_SA(0, 1), a2 + hstep, voffA);
            PG8_WAIT_L(8); PG8_BAR; PG8_WAIT_L(0); PG8_MMA(0, 0, At, B0); PG8_BAR; PG8_SCHED;
            PG8_LDB(B1, 1, 1); PG8_STAGE(PG8_SB(1, 0), b3, voffB);
            PG8_BAR; PG8_WAIT_L(0); PG8_MMA(0, 1, At, B1); PG8_BAR;
            PG8_LDA(At, 1, 1); PG8_STAGE(PG8_SA(1, 0), a3, voffA);
            PG8_BAR; PG8_WAIT_L(0); PG8_MMA(1, 0, At, B0); PG8_BAR; PG8_SCHED;
            PG8_STAGE(PG8_SB(1, 1), b3 + hstep, voffB);
            PG8_WAIT_V(6); PG8_BAR; PG8_MMA(1, 1, At, B1); PG8_BAR;
            }
        }
        if constexpr (ALIGN_EPI) { if (wr == 0) PG8_BAR; }
        if constexpr (!Epi::AFTER_DRAIN) { int t2_ = threadIdx.x; asm volatile("" : "+v"(t2_)); const int l2_ = t2_ & 63; E(acc, cur, nxt, has_next, rsv, wr, wc, l2_ & 15, l2_ >> 4, lds); S.done(cur); }
        if (!has_next) break;
#pragma unroll
        for (int a = 0; a < 2; ++a)
#pragma unroll
            for (int b = 0; b < 2; ++b)
#pragma unroll
                for (int m = 0; m < 4; ++m)
#pragma unroll
                    for (int n = 0; n < 2; ++n) acc[a][b][m][n] = (f32x4){0.f, 0.f, 0.f, 0.f};
        cur = nxt; cA = nA; cB = nB; cst = nst; ++ui;
        if constexpr (ALIGN_EPI) { if (wr == 1) PG8_BAR; }
    }
    PG8_WAIT_V(0);
    if constexpr (!ALIGN_EPI) { if (wr == 0) PG8_BAR; }
    PG8_BAR;
    if constexpr (Epi::AFTER_DRAIN) { E.fused(acc, cur, wr, wc, fr, fq, lds, wid, lane); S.done(cur); }
#undef PG8_SA
#undef PG8_SB
#undef PG8_STAGE
#undef PG8_LDA
#undef PG8_LDB
#undef PG8_MMA
#undef PG8_WAIT_V
#undef PG8_WAIT_L
#undef PG8_BAR
#undef PG8_SCHED
}
}
constexpr int NWAVES = 8;
constexpr int BATCH = 8, SEQ = 2048, D = 1024, FF = 2816, PLE = 256, DEPTH = 4, CHUNK = 128, NGRP = 8;
constexpr int M = BATCH * SEQ;
constexpr size_t MiB = 1u << 20;
constexpr size_t WS_CTL = 0, CTL_ZERO_BYTES = 65536;
constexpr size_t WS_ST0 = 1 * MiB, WS_ST1 = 2 * MiB, WS_VST = 3 * MiB;
constexpr size_t WS_W = 5 * MiB;
constexpr size_t W_LAYER = 19 * MiB, W_GU = 0, W_DN = 11 * MiB, W_PG = 16 * MiB + MiB / 2, W_PP = 18 * MiB + MiB / 2;
constexpr size_t W_CONV = 76 * MiB, W_CONV_STRIDE = 8 * MiB, W_CIN = 0, W_COUT = 6 * MiB;
constexpr size_t W_SG = 92 * MiB, W_SG_STRIDE = 6 * MiB + MiB / 2, W_SIN = 0, W_SOUT = 4 * MiB, W_SS = 6 * MiB;
constexpr size_t WS_PB = 110 * MiB;
constexpr size_t WS_HB0 = 142 * MiB, WS_HB1 = 174 * MiB;
constexpr size_t WS_PROJ = 206 * MiB;
constexpr size_t WS_R = 238 * MiB;
constexpr size_t WS_END = 326 * MiB;
static_assert(pg8::EW_ST0 == WS_ST0 && pg8::EW_ST1 == WS_ST1 && pg8::EW_VST == WS_VST && pg8::EW_HB0 == WS_HB0 && pg8::EW_HB1 == WS_HB1 && pg8::EW_PROJ == WS_PROJ && pg8::EW_R == WS_R, "epilogue offsets vs workspace map");
#define XCD_BAR_WORDS_OFF 1024
constexpr int RING_BYTES = 131072, LDSCTL_OFF = RING_BYTES, MISC_OFF = LDSCTL_OFF + 320, LDS_BYTES = 147456;

#define GAS __attribute__((address_space(1)))
#define LAS __attribute__((address_space(3)))
typedef unsigned short bf16;
typedef unsigned v4u __attribute__((ext_vector_type(4)));
typedef unsigned v2u __attribute__((ext_vector_type(2)));
typedef float f32x4 __attribute__((ext_vector_type(4)));
typedef float f32x2 __attribute__((ext_vector_type(2)));
typedef short bf16x8 __attribute__((ext_vector_type(8)));
#define LDS_WAIT() asm volatile("s_waitcnt lgkmcnt(0)" ::: "memory")
__device__ __forceinline__ unsigned pk2(float lo, float hi) { return pg8::cvt_pk_bf16(lo, hi); }
__device__ __forceinline__ float blo(unsigned u) { return __uint_as_float(u << 16); }
__device__ __forceinline__ float bhi(unsigned u) { return __uint_as_float(u & 0xffff0000u); }

#define XB_TMO      128
#define XB_XCNT(j)  (256  + 64 * (j))
#define XB_XSUB(j)  (1280 + 64 * (j))
#define XB_XGEN(j)  (2304 + 64 * (j))
#define XB_TOP      3328
#define XB_TOPGEN   3392
#define XCD_BAR_WORDS 3456
#define XB_SPIN_CAP (1u << 18)

__device__ __forceinline__ unsigned xb_ld(unsigned* p)              { return __hip_atomic_load(p, __ATOMIC_RELAXED, __HIP_MEMORY_SCOPE_AGENT); }
__device__ __forceinline__ unsigned xb_add(unsigned* p, unsigned v) { return __hip_atomic_fetch_add(p, v, __ATOMIC_RELAXED, __HIP_MEMORY_SCOPE_AGENT); }
__device__ __forceinline__ unsigned xb_xcc_id() { return (unsigned)__builtin_amdgcn_s_getreg((3 << 11) | 20) & 0xFu; }
#define XB_SPIN(cond, bar) do { unsigned _sp = 0; while (cond) { __builtin_amdgcn_s_sleep(1); \
    if ((++_sp & 255u) == 0u) { if (xb_ld(&(bar)[XB_TMO])) break; if (_sp > XB_SPIN_CAP) { atomicAdd(&(bar)[XB_TMO], 1u); break; } } } } while (0)

struct XcdBarrier {
    unsigned* bar; unsigned x;
    volatile LAS unsigned* st;
};

__device__ __forceinline__ XcdBarrier xcd_barrier_post(unsigned* bar, volatile LAS unsigned* st) {
    XcdBarrier b; b.bar = bar; b.x = xb_xcc_id(); b.st = st;
    if (threadIdx.x == 0) (void)xb_add(&bar[XB_XCNT(b.x)], 1u);
    return b;
}
__device__ __forceinline__ void xcd_barrier_complete(unsigned* bar, unsigned x, unsigned& nloc, unsigned& nx) {
    const unsigned G = gridDim.x * gridDim.y * gridDim.z;
    unsigned sum, cnt, mine, sp = 0u;
    for (;;) {
        sum = 0u; cnt = 0u; mine = 0u;
#pragma unroll
        for (unsigned j = 0; j < 16; ++j) { const unsigned c = xb_ld(&bar[XB_XCNT(j)]); sum += c; cnt += (c > 0u) ? 1u : 0u; mine = (j == x) ? c : mine; }
        if (sum == G) break;
        __builtin_amdgcn_s_sleep(1);
        if ((++sp & 255u) == 0u) { if (xb_ld(&bar[XB_TMO])) break; if (sp > XB_SPIN_CAP) { atomicAdd(&bar[XB_TMO], 1u); break; } }
    }
    nloc = mine > 0u ? mine : 1u; nx = cnt > 0u ? cnt : 1u;
}

__device__ __forceinline__ void xcd_barrier(const XcdBarrier& b) {
    asm volatile("s_waitcnt vmcnt(0)" ::: "memory");
    __syncthreads();
    if (threadIdx.x == 0) {
        unsigned* bar = b.bar; unsigned bx = b.x; asm volatile("" : "+s"(bx));
        __builtin_amdgcn_s_waitcnt(0);
        unsigned nloc = b.st[0], nx = b.st[1];
        if (nloc == 0u) { xcd_barrier_complete(bar, bx, nloc, nx); b.st[0] = nloc; b.st[1] = nx; }
        const unsigned old = xb_add(&bar[XB_XSUB(bx)], 1u);
        const unsigned gen = old / nloc;
        if (old + 1u == (gen + 1u) * nloc) {
            __builtin_amdgcn_fence(__ATOMIC_RELEASE, "agent");
            asm volatile("s_waitcnt vmcnt(0)" ::: "memory");
            const unsigned og = xb_add(&bar[XB_TOP], 1u);
            const unsigned tg = og / nx;
            asm volatile("buffer_inv sc1" ::: "memory");
            if (og + 1u == (tg + 1u) * nx) xb_add(&bar[XB_TOPGEN], 1u);
            else XB_SPIN(xb_ld(&bar[XB_TOPGEN]) == tg, bar);
            xb_add(&bar[XB_XGEN(bx)], 1u);
            asm volatile("s_waitcnt vmcnt(0)" ::: "memory");
        } else {
            asm volatile("buffer_inv sc1" ::: "memory");
            XB_SPIN(xb_ld(&bar[XB_XGEN(bx)]) == gen, bar);
            asm volatile("s_waitcnt vmcnt(0)" ::: "memory");
        }
    }
    __syncthreads();
}
__device__ __forceinline__ float wave_sum(float v) {
#pragma unroll
    for (int o = 1; o < 64; o <<= 1) v += __shfl_xor(v, o);
    return v;
}
__device__ __forceinline__ void tr_item(const float* W, int ldw, int K, int src_col0, bf16* WT, int dst_row0, int kb, const float* gain, LAS float* scr, int lane) {
    const int k0 = 64 * kb, c4 = (lane & 7) * 4, r8 = lane >> 3;
    f32x4 v[8]; float gg[8];
#pragma unroll
    for (int i = 0; i < 8; ++i) { v[i] = __builtin_nontemporal_load((const f32x4*)(W + (size_t)(k0 + 8 * i + r8) * ldw + src_col0 + c4)); gg[i] = gain ? gain[k0 + 8 * i + r8] : 1.f; }
#pragma unroll
    for (int i = 0; i < 8; ++i) { LAS float* sp = scr + (8 * i + r8) * 33 + c4; sp[0] = v[i][0] * gg[i]; sp[1] = v[i][1] * gg[i]; sp[2] = v[i][2] * gg[i]; sp[3] = v[i][3] * gg[i]; }
    LDS_WAIT(); asm volatile("" ::: "memory");
    const int c = lane & 7;
#pragma unroll
    for (int j = 0; j < 4; ++j) { const int n = (lane >> 3) + 8 * j; const LAS float* s = scr + (8 * c) * 33 + n;
        v4u o; o.x = pk2(s[0 * 33], s[1 * 33]); o.y = pk2(s[2 * 33], s[3 * 33]); o.z = pk2(s[4 * 33], s[5 * 33]); o.w = pk2(s[6 * 33], s[7 * 33]);
        pg8::st16(WT, (unsigned)((dst_row0 + n) * K + k0 + 8 * c), o); }
    LDS_WAIT(); asm volatile("" ::: "memory");
}
struct Args { const float* in[20]; float* out; unsigned char* ws; };

__device__ __forceinline__ void prologue(const Args& a, LAS unsigned char* lds, int vcu, int G, int wave, int lane, int tid) {
    LAS float* scr = (LAS float*)(lds + wave * 16384);
    const int gw = vcu * NWAVES + wave, NGW = G * NWAVES;
    unsigned char* ws = a.ws;
    constexpr int I_GU = 16 * 176, I_DN = 44 * 32, I_PG = 16 * 32, I_PP = 4 * 32, I_CIN = 16 * 96, I_COUT = 16 * 32, I_SIN = 16 * 64, I_SOUT = 16 * 32;
    constexpr int I_COMMON = I_GU + I_DN + I_PG + I_PP, I_CONVL = I_COMMON + I_CIN + I_COUT, I_SGL = I_COMMON + I_SIN + I_SOUT, I_PAIR = I_CONVL + I_SGL;
    for (int it = gw; it < 2 * I_PAIR; it += NGW) {
        const int j = it / I_PAIR; int r = it % I_PAIR; int L = 2 * j; bool conv = true;
        if (r >= I_CONVL) { r -= I_CONVL; L += 1; conv = false; }
        unsigned char* wl = ws + WS_W + (size_t)L * W_LAYER;
        if (r < I_GU) { const int kb = r / 176, nb = r % 176, tile = nb >> 3, w = (nb & 7) * 32;
            const float* src = (w < 128 ? a.in[13] : a.in[14]) + (size_t)L * D * FF;
            tr_item(src, FF, D, tile * 128 + (w & 127), (bf16*)(wl + W_GU), nb * 32, kb, a.in[12] + L * D, scr, lane); continue; } r -= I_GU;
        if (r < I_DN) { const int kb = r / 32, nb = r % 32; tr_item(a.in[15] + (size_t)L * FF * D, D, FF, nb * 32, (bf16*)(wl + W_DN), nb * 32, kb, nullptr, scr, lane); continue; } r -= I_DN;
        if (r < I_PG) { const int kb = r / 32, nb = r % 32; tr_item(a.in[17] + (size_t)L * D * D, D, D, nb * 32, (bf16*)(wl + W_PG), nb * 32, kb, a.in[16] + L * D, scr, lane); continue; } r -= I_PG;
        if (r < I_PP) { const int kb = r / 32, nb = r % 32; tr_item(a.in[18] + (size_t)L * PLE * D, D, PLE, nb * 32, (bf16*)(wl + W_PP), nb * 32, kb, nullptr, scr, lane); continue; } r -= I_PP;
        if (conv) {
            unsigned char* wc_ = ws + WS_W + W_CONV + (size_t)j * W_CONV_STRIDE;
            if (r < I_CIN) { const int kb = r / 96, nb = r % 96, tile = nb >> 3, w = (nb & 7) * 32;
                const int sc = tile < 8 ? ((w < 128 ? 1024 : 2048) + tile * 128 + (w & 127)) : ((tile - 8) * 256 + w);
                tr_item(a.in[3] + (size_t)j * D * 3 * D, 3 * D, D, sc, (bf16*)(wc_ + W_CIN), nb * 32, kb, a.in[2] + L * D, scr, lane); continue; } r -= I_CIN;
            { const int kb = r / 32, nb = r % 32; tr_item(a.in[5] + (size_t)j * D * D, D, D, nb * 32, (bf16*)(wc_ + W_COUT), nb * 32, kb, nullptr, scr, lane); }
        } else {
            unsigned char* wsg = ws + WS_W + W_SG + (size_t)j * W_SG_STRIDE;
            if (r < I_SIN) { const int kb = r / 64, nb = r % 64; tr_item(a.in[6] + (size_t)j * D * 2 * D, 2 * D, D, nb * 32, (bf16*)(wsg + W_SIN), nb * 32, kb, a.in[2] + L * D, scr, lane); continue; } r -= I_SIN;
            { const int kb = r / 32, nb = r % 32; tr_item(a.in[11] + (size_t)j * D * D, D, D, nb * 32, (bf16*)(wsg + W_SOUT), nb * 32, kb, nullptr, scr, lane); }
        }
    }
    const int gt = vcu * NWAVES * 64 + tid, GT = G * NWAVES * 64;
    for (int i = gt; i < 2 * NGRP * CHUNK * CHUNK / 8; i += GT) {
        const int j = i / (NGRP * CHUNK * CHUNK / 8), e = (i % (NGRP * CHUNK * CHUNK / 8)) * 8, t = (e >> 7) & 127, s0 = e & 127;
        const f32x4* sp = (const f32x4*)(a.in[9] + (size_t)j * NGRP * CHUNK * CHUNK + e); f32x4 x0 = sp[0], x1 = sp[1];
        float v[8] = {x0[0], x0[1], x0[2], x0[3], x1[0], x1[1], x1[2], x1[3]};
#pragma unroll
        for (int k = 0; k < 8; ++k) if (s0 + k > t) v[k] = 0.f;
        v4u o; o.x = pk2(v[0], v[1]); o.y = pk2(v[2], v[3]); o.z = pk2(v[4], v[5]); o.w = pk2(v[6], v[7]);
        pg8::st16((bf16*)(ws + WS_W + W_SG + (size_t)j * W_SG_STRIDE + W_SS), (unsigned)e, o);
    }
    for (int i = gt; i < DEPTH * M * PLE / 8; i += 4 * GT) {
        f32x4 x0[4], x1[4];
#pragma unroll
        for (int k = 0; k < 4; ++k) { const f32x4* sp = (const f32x4*)(a.in[1] + (size_t)(i + k * GT) * 8); x0[k] = __builtin_nontemporal_load(sp); x1[k] = __builtin_nontemporal_load(sp + 1); }
#pragma unroll
        for (int k = 0; k < 4; ++k) { v4u o; o.x = pk2(x0[k][0], x0[k][1]); o.y = pk2(x0[k][2], x0[k][3]); o.z = pk2(x1[k][0], x1[k][1]); o.w = pk2(x1[k][2], x1[k][3]);
            pg8::st16((bf16*)(ws + WS_PB), (unsigned)(i + k * GT) * 8u, o); }
    }
    for (int m = gw; m < M; m += 2 * NGW) {
        f32x4 v[2][4]; float s[2];
#pragma unroll
        for (int r = 0; r < 2; ++r) { const f32x4* xr = (const f32x4*)(a.in[0] + (size_t)(m + r * NGW) * D) + lane;
#pragma unroll
            for (int k = 0; k < 4; ++k) v[r][k] = __builtin_nontemporal_load(xr + 64 * k); }
#pragma unroll
        for (int r = 0; r < 2; ++r) { s[r] = 0.f;
#pragma unroll
            for (int k = 0; k < 4; ++k) s[r] += (v[r][k][0] * v[r][k][0] + v[r][k][1] * v[r][k][1]) + (v[r][k][2] * v[r][k][2] + v[r][k][3] * v[r][k][3]);
            s[r] = wave_sum(s[r]);
            v2u* o8 = (v2u*)((bf16*)(ws + WS_HB0) + (size_t)(m + r * NGW) * D) + lane;
#pragma unroll
            for (int k = 0; k < 4; ++k) { v2u o; o.x = pk2(v[r][k][0], v[r][k][1]); o.y = pk2(v[r][k][2], v[r][k][3]); o8[64 * k] = o; }
            if (lane < 4) ((float*)(ws + WS_ST0))[(size_t)(m + r * NGW) * 4 + lane] = lane == 0 ? s[r] : 0.f; }
    }
}

constexpr int VT_STRIDE = 272;
__device__ __forceinline__ void spatial_mid(const bf16* V, const bf16* U, bf16* OUT, const float* vst, const bf16* Wsb, const float* vgain, const float* vbias, const float* bsp,
                                            LAS unsigned char* lds, int vcu, int G, int wave, int lane, int tid) {
    LAS f32x2* mr = (LAS f32x2*)lds;
    LAS unsigned char* vT = lds + 1024;
    const int fr = lane & 15, fq = lane >> 4;
    for (int it = vcu; it < (M / CHUNK) * NGRP; it += G) {
        const int g = it & 7, c = it >> 3; const size_t rbase = (size_t)c * CHUNK;
        const int t0 = 16 * wave, nks = (wave >> 1) + 1;
        f32x4 sp8[8];
        if (tid < 128) { const f32x4* sp = (const f32x4*)(vst + (rbase + tid) * 32);
#pragma unroll
            for (int k = 0; k < 8; ++k) sp8[k] = sp[k]; }
        const int dc = (tid & 15) * 8;
        v4u vu[4];
#pragma unroll
        for (int k = 0; k < 4; ++k) vu[k] = *(const v4u*)(V + (rbase + ((tid + 512 * k) >> 4)) * D + g * 128 + dc);
        const f32x4* gp = (const f32x4*)(vgain + g * 128 + dc); const f32x4* bp = (const f32x4*)(vbias + g * 128 + dc);
        const f32x4 g0 = gp[0], g1 = gp[1], b0 = bp[0], b1 = bp[1];
        const bf16* wrow = Wsb + ((size_t)(g * 128 + t0 + fr)) * 128 + 8 * fq;
        bf16x8 wf[4];
#pragma unroll
        for (int ks = 0; ks < 4; ++ks) wf[ks] = *(const bf16x8*)(wrow + 32 * (ks < nks ? ks : 0));
        const float bs = bsp[g * 128 + t0 + fr];
        const bf16* urow = U + (rbase + t0 + fr) * D + g * 128 + 4 * fq; bf16* orow = OUT + (rbase + t0 + fr) * D + g * 128 + 4 * fq;
        v2u uu[8];
#pragma unroll
        for (int db = 0; db < 8; ++db) uu[db] = *(const v2u*)(urow + 16 * db);
        if (tid < 128) { float s = 0.f, q = 0.f;
#pragma unroll
            for (int k = 0; k < 8; ++k) { s += sp8[k][0] + sp8[k][2]; q += sp8[k][1] + sp8[k][3]; }
            const float mean = s * (1.0f / 1024.0f), var = fmaxf(q * (1.0f / 1024.0f) - mean * mean, 0.f);
            mr[tid] = (f32x2){mean, __builtin_amdgcn_rsqf(var + 1e-5f)};
        }
        __syncthreads();
        const float gg[8] = {g0[0], g0[1], g0[2], g0[3], g1[0], g1[1], g1[2], g1[3]}, bb[8] = {b0[0], b0[1], b0[2], b0[3], b1[0], b1[1], b1[2], b1[3]};
#pragma unroll
        for (int k = 0; k < 4; ++k) {
            const int s = (tid + 512 * k) >> 4;
            const f32x2 st = mr[s];
            const float x[8] = {blo(vu[k].x), bhi(vu[k].x), blo(vu[k].y), bhi(vu[k].y), blo(vu[k].z), bhi(vu[k].z), blo(vu[k].w), bhi(vu[k].w)};
#pragma unroll
            for (int i = 0; i < 8; ++i) { const float y = (x[i] - st.x) * st.y * gg[i] + bb[i]; const unsigned pk = pk2(y, 0.f);
                *(LAS unsigned short*)(vT + (dc + i) * VT_STRIDE + s * 2) = (unsigned short)pk; }
        }
        __syncthreads();
        pg8::f32x4 acc[8];
#pragma unroll
        for (int db = 0; db < 8; ++db) acc[db] = (pg8::f32x4){0.f, 0.f, 0.f, 0.f};
#pragma unroll
        for (int ks = 0; ks < 4; ++ks) {
            if (ks < nks) {
#pragma unroll
                for (int db = 0; db < 8; ++db) {
                    const bf16x8 vf = *(const LAS bf16x8*)(vT + (16 * db + fr) * VT_STRIDE + (32 * ks + 8 * fq) * 2);
                    acc[db] = __builtin_amdgcn_mfma_f32_16x16x32_bf16(vf, wf[ks], acc[db], 0, 0, 0);
                }
            }
        }
#pragma unroll
        for (int db = 0; db < 8; ++db) {
            v2u o; o.x = pk2(blo(uu[db].x) * (acc[db][0] + bs), bhi(uu[db].x) * (acc[db][1] + bs)); o.y = pk2(blo(uu[db].y) * (acc[db][2] + bs), bhi(uu[db].y) * (acc[db][3] + bs));
            *(v2u*)(orow + 16 * db) = o;
        }
        __syncthreads();
    }
}

__device__ __forceinline__ void final_norm(float* out, const bf16* h, const float* stats, const float* gain, int gw, int NGW, int lane) {
    f32x4 gv[4];
#pragma unroll
    for (int k = 0; k < 4; ++k) gv[k] = ((const f32x4*)gain)[lane + 64 * k];
    for (int m = gw; m < M; m += NGW) {
        const f32x4 a = *(const f32x4*)(stats + (size_t)m * 4);
        const float rs = __builtin_amdgcn_rsqf(((a[0] + a[1]) + (a[2] + a[3])) * (1.0f / 1024.0f) + 1e-6f);
        const v2u* hr = (const v2u*)(h + (size_t)m * D) + lane; f32x4* xr = (f32x4*)(out + (size_t)m * D) + lane;
        v2u hv[4];
#pragma unroll
        for (int k = 0; k < 4; ++k) hv[k] = hr[64 * k];
#pragma unroll
        for (int k = 0; k < 4; ++k) { const f32x4 v = (f32x4){blo(hv[k].x), bhi(hv[k].x), blo(hv[k].y), bhi(hv[k].y)}; xr[64 * k] = v * rs * gv[k]; }
    }
}
#ifndef STAGGER
#define STAGGER 0
#endif
#ifndef REP_G2
#define REP_G2 1
#endif
#ifndef REP_DN
#define REP_DN 1
#endif
#ifndef REP_PL
#define REP_PL 1
#endif
#ifndef REP_MID
#define REP_MID 1
#endif
#ifndef PERMUTE_BLOCKS
#define PERMUTE_BLOCKS 0
#endif
#ifndef REP_PRO
#define REP_PRO 1
#endif
#ifndef REP_G1
#define REP_G1 1
#endif
#ifndef REP_UP
#define REP_UP 1
#endif
#ifndef REP_PJ
#define REP_PJ 1
#endif
__global__ void __launch_bounds__(NWAVES * 64, 2) trunk_fwd(Args args) {
    extern __shared__ __attribute__((aligned(16))) unsigned char lds_raw[];
    LAS unsigned char* lds = (LAS unsigned char*)lds_raw;
    const int tid = threadIdx.x, lane = tid & 63, wave = __builtin_amdgcn_readfirstlane(tid >> 6);
    const int G = gridDim.x; const int lbx = PERMUTE_BLOCKS ? (int)((blockIdx.x * 37u + 11u) % (unsigned)gridDim.x) : (int)blockIdx.x;
    int vcu; { const int bx = lbx; vcu = (G % 8 == 0) ? (bx % 8) * (G / 8) + bx / 8 : bx; }
    unsigned char* ws = args.ws;
    for (int u = tid; u < (LDS_BYTES - LDSCTL_OFF) / 4; u += NWAVES * 64) ((LAS unsigned*)(lds + LDSCTL_OFF))[u] = 0u;
    __syncthreads();
    volatile LAS unsigned* MISC = (volatile LAS unsigned*)(lds + MISC_OFF);
    XcdBarrier bar = xcd_barrier_post((unsigned*)(ws + WS_CTL) + XCD_BAR_WORDS_OFF, MISC + 8);

    for (int rp = 0; rp < REP_PRO; ++rp) prologue(args, lds, vcu, G, wave, lane, tid);
    if (args.ws == nullptr) cg::this_grid().sync();
    xcd_barrier(bar);

    int sb = 0;
    for (int L = 0; L < DEPTH; ++L) {
        const int j = L >> 1; const bool conv = (L & 1) == 0;
        unsigned char* wl = ws + WS_W + (size_t)L * W_LAYER;
        unsigned char* wm = conv ? ws + WS_W + W_CONV + (size_t)j * W_CONV_STRIDE : ws + WS_W + W_SG + (size_t)j * W_SG_STRIDE;
        for (int s = 0; s < 7; ++s) {
            if (s == 1 && !conv) {
                int tid = threadIdx.x; asm volatile("" : "+v"(tid)); const int lane = tid & 63;
                for (int rp = 0; rp < REP_MID; ++rp) {
                    bf16* mo = (bf16*)(ws + (rp + 1 < REP_MID ? WS_PROJ : WS_R));
                    spatial_mid((const bf16*)(ws + WS_R + 32 * MiB), (const bf16*)(ws + WS_R), mo, (const float*)(ws + WS_VST), (const bf16*)(wm + W_SS),
                                     args.in[7] + (size_t)j * D, args.in[8] + (size_t)j * D, args.in[10] + (size_t)j * NGRP * CHUNK, lds, vcu, G, wave, lane, tid);
                }
            } else {
                const int rem_up = (M / 256) * (2 * FF / 256) % G;
                const int ls = (STAGGER && rem_up != 0 && lbx >= rem_up && (s == 3 || s == 4)) ? 7 - s : s;
                pg8::Gemm g; pg8::Epi E;
                E.sb = sb; E.ws = ws; E.aux = nullptr;
                g.M = M; g.K = D; g.N = D; g.A = (const bf16*)(ws + (sb ? WS_HB1 : WS_HB0)); g.Bt = nullptr; E.mode = pg8::MODE_RES;
                bool upd = false;
                if (ls == 0) { g.Bt = (const bf16*)(wm + (conv ? W_CIN : W_SIN)); g.N = 2 * D; E.mode = conv ? pg8::MODE_CONV_IN : pg8::MODE_SG_IN; }
                else if (ls == 1) { g.Bt = (const bf16*)(wm + W_CIN) + (size_t)2 * D * D; E.mode = pg8::MODE_CONV_B; E.aux = args.in[4] + (size_t)j * 3 * D; }
                else if (ls == 2) { g.A = (const bf16*)(ws + WS_R); g.Bt = (const bf16*)(wm + (conv ? W_COUT : W_SOUT)); E.mode = pg8::MODE_RES; upd = true; }
                else if (ls == 3) { g.Bt = (const bf16*)(wl + W_GU); g.N = 2 * FF; E.mode = pg8::MODE_FFN_UP; }
                else if (ls == 4) { g.A = (const bf16*)(ws + WS_PB) + (size_t)L * M * PLE; g.Bt = (const bf16*)(wl + W_PP); g.K = PLE; E.mode = pg8::MODE_PROJ; }
                else if (ls == 5) { g.A = (const bf16*)(ws + WS_R); g.Bt = (const bf16*)(wl + W_DN); g.K = FF; E.mode = pg8::MODE_RES; upd = true; }
                else { g.Bt = (const bf16*)(wl + W_PG); E.mode = pg8::MODE_PLE; upd = true; }
                pg8::StaticOrder S; S.init(M, g.N, G, lbx);
                if (ls == 4) { const int rem = (M / 256) * (2 * FF / 256) % G;
                    if (rem != 0) { if (lbx >= rem) S.init(M, g.N, G - rem, lbx - rem); else S.nwg = 0; } }
                const int nrep = (ls == 0) ? REP_G1 : (ls == 3) ? REP_UP : (ls == 4) ? REP_PJ : (ls == 2) ? REP_G2 : (ls == 5) ? REP_DN : (ls == 6) ? REP_PL : 1;
                const int real_mode = E.mode;
                for (int rp = 0; rp < nrep; ++rp) { E.mode = (rp + 1 < nrep && (real_mode == pg8::MODE_RES || real_mode == pg8::MODE_PLE)) ? pg8::MODE_NOP : real_mode; pg8::gemm_phase<pg8::Epi, pg8::StaticOrder, true, true>(lds, g, S, E); }
                if (upd) sb ^= 1;
            }
            if (s != 3) xcd_barrier(bar);
        }
    }
    int tf = threadIdx.x; asm volatile("" : "+v"(tf));
    final_norm(args.out, (const bf16*)(ws + (sb ? WS_HB1 : WS_HB0)), (const float*)(ws + (sb ? WS_ST1 : WS_ST0)), args.in[19], vcu * NWAVES + (tf >> 6), G * NWAVES, tf & 63);
}

extern "C" void kernel_launch(void* const* d_in, const int* in_sizes, int n_in, void* d_out, int out_size, void* d_ws, size_t ws_size, hipStream_t stream) {
    static int grid = 0;
    if (grid == 0) {
        if (n_in != 20 || in_sizes[0] != M * D || out_size != M * D || ws_size < WS_END) { fprintf(stderr, "kernel_launch: unexpected shapes (n_in %d, in0 %d, out %d, ws %zu)\n", n_in, n_in > 0 ? in_sizes[0] : -1, out_size, ws_size); grid = -1; return; }
        int dev = 0, cus = 0, per_cu = 0;
        if (hipGetDevice(&dev) != hipSuccess || hipDeviceGetAttribute(&cus, hipDeviceAttributeMultiprocessorCount, dev) != hipSuccess) { grid = -1; return; }
        if (hipFuncSetAttribute((const void*)trunk_fwd, hipFuncAttributeMaxDynamicSharedMemorySize, LDS_BYTES) != hipSuccess) { fprintf(stderr, "kernel_launch: hipFuncSetAttribute failed\n"); grid = -1; return; }
        if (hipOccupancyMaxActiveBlocksPerMultiprocessor(&per_cu, (const void*)trunk_fwd, NWAVES * 64, LDS_BYTES) != hipSuccess || per_cu < 1) { fprintf(stderr, "kernel_launch: occupancy query says %d\n", per_cu); (void)hipGetLastError(); grid = -1; return; }
        grid = cus * (per_cu < 1 ? 1 : 1);
    }
    if (grid < 0) return;
    if (hipMemsetAsync((char*)d_ws + WS_CTL, 0, CTL_ZERO_BYTES, stream) != hipSuccess) return;
    Args a{};
    for (int i = 0; i < 20; ++i) a.in[i] = (const float*)d_in[i];
    a.out = (float*)d_out; a.ws = (unsigned char*)d_ws;
    void* kargs[] = {&a};
    hipError_t e = hipLaunchCooperativeKernel((const void*)trunk_fwd, dim3(grid), dim3(NWAVES * 64), kargs, LDS_BYTES, stream);
    if (e != hipSuccess) fprintf(stderr, "kernel_launch: cooperative launch failed: %s (grid %d)\n", hipGetErrorString(e), grid);
}
```
